# Optimizing an MI355X kernel written in HIP

```python
import math
import jax, jax.numpy as jnp
from jax import lax
import numpy as np

D_MODEL = 1024
BATCH = 4
SEQ = 8192
DEPTH = 2

D_MIX = D_MODEL
N_MIXERS = 4
D_BRANCH = D_MIX // N_MIXERS
HEAD_DIM = 64
N_HEADS_BRANCH = D_BRANCH // HEAD_DIM

SSM_STATE = 64
SSM_GROUPS = 2
SSM_CONV = 4
SSM_CHUNK = 128
SSM_XBC = D_BRANCH + 2 * SSM_GROUPS * SSM_STATE
HGRN_CHUNK = 64
RET_CHUNK = 128
MOBA_BLOCK = 256
MOBA_TOPK = 3
MOBA_QBLOCK = 128

LN_EPS = 1e-5
RMS_EPS = 1e-6
DEEPNORM_ALPHA = (2.0 * DEPTH) ** 0.25
DEEPNORM_BETA = (8.0 * DEPTH) ** -0.25

SPLIT_SIZES = (D_BRANCH, SSM_XBC, N_HEADS_BRANCH,
               D_BRANCH, D_BRANCH, D_BRANCH, D_BRANCH,
               D_BRANCH, D_BRANCH, D_BRANCH, D_BRANCH,
               D_BRANCH, D_BRANCH, D_BRANCH, D_BRANCH)
N_IN = sum(SPLIT_SIZES)

kernel_name = "hymba_ssd_hgrn2_retnet_moba_deepnorm"

F32 = jnp.float32


def _layernorm(x, g, b):
    xf = x.astype(F32)
    mu = jnp.mean(xf, -1, keepdims=True)
    var = jnp.mean(jnp.square(xf - mu), -1, keepdims=True)
    return ((xf - mu) * lax.rsqrt(var + LN_EPS) * g + b).astype(x.dtype)


def _rms(x):
    xf = x.astype(F32)
    return xf * lax.rsqrt(jnp.mean(xf * xf, -1, keepdims=True) + RMS_EPS)


def _groupnorm(x):
    xf = x.astype(F32)
    mu = jnp.mean(xf, -1, keepdims=True)
    var = jnp.mean(jnp.square(xf - mu), -1, keepdims=True)
    return (xf - mu) * lax.rsqrt(var + LN_EPS)


def _segsum(a):
    T = a.shape[-1]
    rep = jnp.broadcast_to(a[..., :, None], a.shape + (T,))
    idx = jnp.arange(T)
    rep = jnp.where(idx[:, None] > idx[None, :], rep, 0.0)
    cs = jnp.cumsum(rep, axis=-2)
    return jnp.where(idx[:, None] >= idx[None, :], cs, -jnp.inf)


def _ssd(z, xbc_raw, dt_raw, conv_w, conv_b, dt_bias, a_log, d_skip, norm_w):
    Bsz, L, ch = xbc_raw.shape
    H, P, G, N, C = N_HEADS_BRANCH, HEAD_DIM, SSM_GROUPS, SSM_STATE, SSM_CHUNK
    nc = L // C
    xbc = lax.conv_general_dilated(xbc_raw, conv_w[:, None, :], window_strides=(1,),
                                   padding=((SSM_CONV - 1, 0),),
                                   dimension_numbers=('NWC', 'WIO', 'NWC'),
                                   feature_group_count=ch) + conv_b
    xbc = jax.nn.silu(xbc)
    xs, Bm, Cm = jnp.split(xbc, [D_BRANCH, D_BRANCH + G * N], axis=-1)
    xs = xs.reshape(Bsz, nc, C, H, P)
    Bm = jnp.repeat(Bm.reshape(Bsz, nc, C, G, N), H // G, axis=3)
    Cm = jnp.repeat(Cm.reshape(Bsz, nc, C, G, N), H // G, axis=3)
    dt = jax.nn.softplus(dt_raw.astype(F32) + dt_bias)
    A = -jnp.exp(a_log.astype(F32))
    dt4 = dt.reshape(Bsz, nc, C, H)
    a = (dt4 * A).transpose(0, 3, 1, 2)
    a_cum = jnp.cumsum(a, axis=-1)
    xdt = xs * dt4[..., None]
    Lmat = jnp.exp(_segsum(a))
    scores = jnp.einsum('bclhn,bcshn->bhcls', Cm, Bm) * Lmat
    y_diag = jnp.einsum('bhcls,bcshp->bclhp', scores, xdt)
    decay_states = jnp.exp(a_cum[..., -1:] - a_cum)
    states = jnp.einsum('bclhn,bhcl,bclhp->bchpn', Bm, decay_states, xdt)
    states = jnp.concatenate([jnp.zeros_like(states[:, :1]), states], axis=1)
    chunk_decay = jnp.exp(_segsum(jnp.pad(a_cum[..., -1], ((0, 0), (0, 0), (1, 0)))))
    new_states = jnp.einsum('bhzc,bchpn->bzhpn', chunk_decay, states)
    prev_states = new_states[:, :-1]
    y_off = jnp.einsum('bclhn,bchpn,bhcl->bclhp', Cm, prev_states, jnp.exp(a_cum))
    y = (y_diag + y_off + xs * d_skip[:, None]).reshape(Bsz, L, D_BRANCH)
    g = (y * jax.nn.silu(z.astype(F32))).reshape(Bsz, L, G, D_BRANCH // G)
    return _rms(g).reshape(Bsz, L, D_BRANCH) * norm_w


def _hgrn2(q, f_raw, i, gate, lb, norm_w):
    Bsz, L, _ = q.shape
    H, dk, C = N_HEADS_BRANCH, HEAD_DIM, HGRN_CHUNK
    nc = L // C
    lbf = lb.astype(F32)
    f = lbf + (1.0 - lbf) * jax.nn.sigmoid(f_raw.astype(F32))
    logf = jnp.log(f)
    k = 1.0 - f

    def chunks(t):
        return t.astype(F32).reshape(Bsz, nc, C, H, dk).transpose(1, 0, 3, 2, 4)

    qs, ks, vs, ls = chunks(q), chunks(k), chunks(i), chunks(logf)
    causal = jnp.tril(jnp.ones((C, C), dtype=bool))

    def step(S, inp):
        qc, kc, vc, lc = inp
        b = jnp.cumsum(lc, axis=2)
        o_inter = jnp.einsum('bhtd,bhdv->bhtv', qc * jnp.exp(b), S)
        diff = b[:, :, :, None, :] - b[:, :, None, :, :]
        diff = jnp.where(causal[None, None, :, :, None], diff, -jnp.inf)
        att = jnp.einsum('bhtd,bhsd,bhtsd->bhts', qc, kc, jnp.exp(diff))
        o_intra = jnp.einsum('bhts,bhsv->bhtv', att, vc)
        b_last = b[:, :, -1]
        S_new = jnp.exp(b_last)[..., None] * S + jnp.einsum(
            'bhsd,bhsv->bhdv', kc * jnp.exp(b_last[:, :, None] - b), vc)
        return S_new, o_inter + o_intra

    S0 = jnp.zeros((Bsz, H, dk, dk), F32)
    _, o = lax.scan(step, S0, (qs, ks, vs, ls))
    o = o.transpose(1, 0, 3, 2, 4).reshape(Bsz, L, H, dk)
    o = (_rms(o) * norm_w.reshape(H, dk)).reshape(Bsz, L, D_BRANCH)
    return o * jax.nn.silu(gate.astype(F32))


def _retention(q, k, v, gate):
    Bsz, L, _ = q.shape
    H, d, C = N_HEADS_BRANCH, HEAD_DIM, RET_CHUNK
    nc = L // C
    log_g = jnp.log(1.0 - 2.0 ** (-5.0 - jnp.arange(H, dtype=F32)))
    qh = q.astype(F32).reshape(Bsz, nc, C, H, d)
    kh = k.astype(F32).reshape(Bsz, nc, C, H, d) * (d ** -0.5)
    vh = v.astype(F32).reshape(Bsz, nc, C, H, d)
    pos = jnp.arange(C, dtype=F32)
    dist = pos[:, None] - pos[None, :]
    intra_decay = jnp.where(dist >= 0, jnp.exp(log_g[:, None, None] * jnp.maximum(dist, 0.0)), 0.0)
    scores = jnp.einsum('bclhd,bcshd->bchls', qh, kh) * intra_decay
    y_intra = jnp.einsum('bchls,bcshv->bclhv', scores, vh)
    k_decay = jnp.exp(log_g[:, None] * (C - 1.0 - pos)[None, :])
    U = jnp.einsum('bcshd,hs,bcshv->bchdv', kh, k_decay, vh)
    chunk_g = jnp.exp(log_g * C)[None, :, None, None]

    def step(R, u):
        return chunk_g * R + u, R

    _, R_prev = lax.scan(step, jnp.zeros((Bsz, H, d, d), F32), U.transpose(1, 0, 2, 3, 4))
    R_prev = R_prev.transpose(1, 0, 2, 3, 4)
    q_decay = jnp.exp(log_g[:, None] * (pos + 1.0)[None, :])
    y_inter = jnp.einsum('bclhd,hl,bchdv->bclhv', qh, q_decay, R_prev)
    y = _groupnorm((y_intra + y_inter).reshape(Bsz, L, H, d)).reshape(Bsz, L, D_BRANCH)
    return y * jax.nn.silu(gate.astype(F32))


def _moba(q, k, v, gate):
    Bsz, L, _ = q.shape
    H, d, S, Q = N_HEADS_BRANCH, HEAD_DIM, MOBA_BLOCK, MOBA_QBLOCK
    nb = -(-L // S)
    pad = nb * S - L

    def heads(t):
        t = jnp.pad(t, ((0, 0), (0, pad), (0, 0)))
        return t.reshape(Bsz, nb * S, H, d).transpose(0, 2, 1, 3)

    qh = heads(q) * (d ** -0.5)
    kh, vh = heads(k), heads(v)
    k_blocks = kh.reshape(Bsz, H, nb, S, d)
    v_blocks = vh.reshape(Bsz, H, nb, S, d)
    k_mean = jnp.mean(k_blocks, axis=3)
    n_sel = min(MOBA_TOPK, nb)
    slopes = 2.0 ** (-8.0 * jnp.arange(1, H + 1, dtype=F32) / H)
    bi = jnp.arange(Bsz)[:, None, None, None]
    hi = jnp.arange(H)[None, :, None, None]
    qb_per_kb = S // Q

    def one_block(qb):
        q0 = qb * Q
        own = qb // qb_per_kb
        qc = lax.dynamic_slice_in_dim(qh, q0, Q, axis=2)
        t_pos = q0 + jnp.arange(Q)
        gsc = jnp.einsum('bhqd,bhnd->bhqn', qc, k_mean).astype(F32)
        gsc = jnp.where(jnp.arange(nb) < own, gsc, -jnp.inf)
        _, sel = lax.top_k(gsc, n_sel)
        valid = jnp.arange(n_sel) < own
        ks = k_blocks[bi, hi, sel]
        vs = v_blocks[bi, hi, sel]
        s_sel = jnp.einsum('bhqd,bhqnsd->bhqns', qc, ks).astype(F32)
        s_pos = sel[..., None] * S + jnp.arange(S)
        rel_sel = (t_pos[:, None, None] - s_pos).astype(F32)
        s_sel = s_sel - slopes[:, None, None, None] * rel_sel
        s_sel = jnp.where(valid[:, None], s_sel, -jnp.inf)
        k_own = lax.dynamic_slice_in_dim(kh, own * S, S, axis=2)
        v_own = lax.dynamic_slice_in_dim(vh, own * S, S, axis=2)
        rel = (t_pos[:, None] - (own * S + jnp.arange(S))[None, :]).astype(F32)
        s_own = jnp.einsum('bhqd,bhsd->bhqs', qc, k_own).astype(F32)
        s_own = jnp.where(rel >= 0, s_own - slopes[:, None, None] * rel, -jnp.inf)
        scores = jnp.concatenate([s_sel.reshape(Bsz, H, Q, n_sel * S), s_own], axis=-1)
        p = jax.nn.softmax(scores, axis=-1)
        p_sel = p[..., :n_sel * S].reshape(Bsz, H, Q, n_sel, S)
        p_own = p[..., n_sel * S:]
        return (jnp.einsum('bhqns,bhqnsd->bhqd', p_sel, vs)
                + jnp.einsum('bhqs,bhsd->bhqd', p_own, v_own))

    outs = lax.map(one_block, jnp.arange(L // Q))
    o = outs.transpose(1, 0, 3, 2, 4).reshape(Bsz, L, D_BRANCH)
    return o * jax.nn.silu(gate.astype(F32))


def _layer(x, w_in, conv_w, conv_b, dt_bias, a_log, d_skip, ssd_norm_w, lb, hgrn_norm_w,
           w_out, ln_g, ln_b):
    proj = jnp.einsum('bld,dn->bln', x, w_in)
    idx = [int(v) for v in np.cumsum(SPLIT_SIZES)[:-1]]
    (s_z, s_xbc, s_dt, h_q, h_f, h_i, h_g, r_q, r_k, r_v, r_g,
     m_q, m_k, m_v, m_g) = jnp.split(proj, idx, axis=-1)
    y_ssd = _ssd(s_z, s_xbc, s_dt, conv_w, conv_b, dt_bias, a_log, d_skip, ssd_norm_w)
    y_hgrn = _hgrn2(h_q, h_f, h_i, h_g, lb, hgrn_norm_w)
    y_ret = _retention(r_q, r_k, r_v, r_g)
    y_moba = _moba(m_q, m_k, m_v, m_g)
    y_cat = jnp.concatenate([y_ssd, y_hgrn, y_ret, y_moba], axis=-1).astype(x.dtype)
    y = jnp.einsum('blm,md->bld', y_cat, w_out)
    return _layernorm(DEEPNORM_ALPHA * x + y, ln_g, ln_b)


def setup_inputs(seed: int = 0) -> dict:
    key = jax.random.key(seed)
    ks = jax.random.split(key, 16)
    offs = np.cumsum((0,) + SPLIT_SIZES)
    col_scale = np.ones((N_IN,), np.float32)
    col_scale[offs[1]:offs[1] + D_BRANCH] = DEEPNORM_BETA
    col_scale[offs[5]:offs[6]] = DEEPNORM_BETA
    col_scale[offs[9]:offs[10]] = DEEPNORM_BETA
    col_scale[offs[13]:offs[14]] = DEEPNORM_BETA
    w_in = (jax.random.normal(ks[3], (DEPTH, D_MODEL, N_IN), F32) * (D_MODEL ** -0.5)
            * jnp.asarray(col_scale))
    dt0 = jnp.exp(jax.random.uniform(ks[6], (DEPTH, N_HEADS_BRANCH), F32,
                                     math.log(1e-3), math.log(1e-1)))
    dt_bias = dt0 + jnp.log(-jnp.expm1(-dt0))
    a_log = jnp.log(jax.random.uniform(ks[7], (DEPTH, N_HEADS_BRANCH), F32, 1.0, 16.0))
    return {
        "x": jax.random.normal(ks[0], (BATCH, SEQ, D_MODEL), F32),
        "emb_ln_g": 1.0 + 0.02 * jax.random.normal(ks[1], (D_MODEL,), F32),
        "emb_ln_b": 0.02 * jax.random.normal(ks[2], (D_MODEL,), F32),
        "w_in": w_in,
        "ssd_conv_w": jax.random.normal(ks[4], (DEPTH, SSM_CONV, SSM_XBC), F32) * (SSM_CONV ** -0.5),
        "ssd_conv_b": 0.02 * jax.random.normal(ks[5], (DEPTH, SSM_XBC), F32),
        "ssd_dt_bias": dt_bias,
        "ssd_a_log": a_log,
        "ssd_d": 1.0 + 0.02 * jax.random.normal(ks[8], (DEPTH, N_HEADS_BRANCH), F32),
        "ssd_norm_w": 1.0 + 0.02 * jax.random.normal(ks[9], (DEPTH, D_BRANCH), F32),
        "hgrn_lb_logits": 0.1 * jax.random.normal(ks[10], (DEPTH, D_BRANCH), F32),
        "hgrn_norm_w": 1.0 + 0.02 * jax.random.normal(ks[11], (DEPTH, D_BRANCH), F32),
        "w_out": jax.random.normal(ks[12], (DEPTH, D_MIX, D_MODEL), F32) * (D_MIX ** -0.5) * DEEPNORM_BETA,
        "ln_g": 1.0 + 0.02 * jax.random.normal(ks[13], (DEPTH, D_MODEL), F32),
        "ln_b": 0.02 * jax.random.normal(ks[14], (DEPTH, D_MODEL), F32),
    }


def reference(x, emb_ln_g, emb_ln_b, w_in, ssd_conv_w, ssd_conv_b, ssd_dt_bias, ssd_a_log,
              ssd_d, ssd_norm_w, hgrn_lb_logits, hgrn_norm_w, w_out, ln_g, ln_b):
    lbs = jnp.cumsum(jax.nn.softmax(hgrn_lb_logits.astype(F32), axis=0), axis=0)
    lbs = lbs - lbs[0]
    h = _layernorm(x, emb_ln_g, emb_ln_b)
    for l in range(DEPTH):
        h = _layer(h, w_in[l], ssd_conv_w[l], ssd_conv_b[l], ssd_dt_bias[l], ssd_a_log[l],
                   ssd_d[l], ssd_norm_w[l], lbs[l], hgrn_norm_w[l], w_out[l], ln_g[l], ln_b[l])
    return h
```

```cpp
#include <hip/hip_runtime.h>
#include <stdint.h>
#include <math.h>

typedef unsigned short bf16_t;
__device__ __forceinline__ float bf2f(bf16_t b) { return __uint_as_float(((unsigned)b) << 16); }
__device__ __forceinline__ bf16_t f2bf(float f) { unsigned u = __float_as_uint(f); u += 0x7fffu + ((u >> 16) & 1u); return (bf16_t)(u >> 16); }
__device__ __forceinline__ float silu_f(float x) { return x / (1.f + __expf(-x)); }
__device__ __forceinline__ float sigmoid_f(float x) { return 1.f / (1.f + __expf(-x)); }
__device__ __forceinline__ float wave_sum(float v) {
#pragma unroll
    for (int o = 1; o < 64; o <<= 1) v += __shfl_xor(v, o);
    return v;
}
__device__ __forceinline__ float wave_max(float v) {
#pragma unroll
    for (int o = 1; o < 64; o <<= 1) v = fmaxf(v, __shfl_xor(v, o));
    return v;
}

constexpr int NB = 4, L = 8192, M = NB * L, D = 1024, NIN = 3844, PLD = 3840;
constexpr int C_SZ = 0, C_XBC = 256, C_HQ = 768, C_HF = 1024, C_HI = 1280, C_HG = 1536, C_RQ = 1792, C_RK = 2048, C_RV = 2304, C_RG = 2560,
              C_MQ = 2816, C_MK = 3072, C_MV = 3328, C_MG = 3584;
constexpr float LN_EPS = 1e-5f, RMS_EPS = 1e-6f;
#define ALPHA 1.4142135623730951f

__global__ __launch_bounds__(256) void k_ln_rows(const float* __restrict__ in, const float* __restrict__ g, const float* __restrict__ b, float* __restrict__ out) {
    const int lane = threadIdx.x & 63, wid = threadIdx.x >> 6;
    const int row = blockIdx.x * 4 + wid;
    const float4* xr = (const float4*)(in + (size_t)row * D) + lane;
    float4 v[4]; float s = 0.f;
#pragma unroll
    for (int j = 0; j < 4; ++j) { v[j] = xr[64 * j]; s += (v[j].x + v[j].y) + (v[j].z + v[j].w); }
    const float mean = wave_sum(s) * (1.f / D); float s2 = 0.f;
#pragma unroll
    for (int j = 0; j < 4; ++j) { v[j].x -= mean; v[j].y -= mean; v[j].z -= mean; v[j].w -= mean; s2 += (v[j].x * v[j].x + v[j].y * v[j].y) + (v[j].z * v[j].z + v[j].w * v[j].w); }
    const float rstd = rsqrtf(wave_sum(s2) * (1.f / D) + LN_EPS);
    float4* o = (float4*)(out + (size_t)row * D) + lane;
#pragma unroll
    for (int j = 0; j < 4; ++j) {
        const float4 gg = ((const float4*)g)[lane + 64 * j], bb = ((const float4*)b)[lane + 64 * j];
        float4 r; r.x = v[j].x * rstd * gg.x + bb.x; r.y = v[j].y * rstd * gg.y + bb.y; r.z = v[j].z * rstd * gg.z + bb.z; r.w = v[j].w * rstd * gg.w + bb.w;
        o[64 * j] = r;
    }
}

template <int MODE>
__global__ __launch_bounds__(256) void k_gemm_naive(const void* __restrict__ Av, const float* __restrict__ W, int N, int K,
                                                    bf16_t* __restrict__ proj, float* __restrict__ dtraw, const float* __restrict__ hres, float* __restrict__ z) {
    __shared__ float As[16][65];
    __shared__ float Ws[16][64];
    const int tx = threadIdx.x & 15, ty = threadIdx.x >> 4;
    const int m0 = blockIdx.y * 64, n0 = blockIdx.x * 64;
    float acc[4][4];
#pragma unroll
    for (int i = 0; i < 4; ++i)
#pragma unroll
        for (int j = 0; j < 4; ++j) acc[i][j] = 0.f;
    for (int k0 = 0; k0 < K; k0 += 16) {
        for (int i = threadIdx.x; i < 1024; i += 256) {
            const int r = i >> 4, c = i & 15;
            float a;
            if (MODE == 0) a = ((const float*)Av)[(size_t)(m0 + r) * K + k0 + c];
            else a = bf2f(((const bf16_t*)Av)[(size_t)(m0 + r) * K + k0 + c]);
            As[c][r] = a;
        }
        for (int i = threadIdx.x; i < 1024; i += 256) { const int r = i >> 6, c = i & 63; const int n = n0 + c; Ws[r][c] = n < N ? W[(size_t)(k0 + r) * N + n] : 0.f; }
        __syncthreads();
#pragma unroll
        for (int kk = 0; kk < 16; ++kk) {
            float a[4], b[4];
#pragma unroll
            for (int i = 0; i < 4; ++i) a[i] = As[kk][ty * 4 + i];
#pragma unroll
            for (int j = 0; j < 4; ++j) b[j] = Ws[kk][tx * 4 + j];
#pragma unroll
            for (int i = 0; i < 4; ++i)
#pragma unroll
                for (int j = 0; j < 4; ++j) acc[i][j] += a[i] * b[j];
        }
        __syncthreads();
    }
#pragma unroll
    for (int i = 0; i < 4; ++i)
#pragma unroll
        for (int j = 0; j < 4; ++j) {
            const int m = m0 + ty * 4 + i, n = n0 + tx * 4 + j;
            if (n >= N) continue;
            if (MODE == 0) {
                if (n < 768) proj[(size_t)m * PLD + n] = f2bf(acc[i][j]);
                else if (n < 772) dtraw[(size_t)m * 4 + (n - 768)] = acc[i][j];
                else proj[(size_t)m * PLD + (n - 4)] = f2bf(acc[i][j]);
            } else {
                z[(size_t)m * N + n] = ALPHA * hres[(size_t)m * N + n] + acc[i][j];
            }
        }
}

__global__ __launch_bounds__(256) void k_conv(const bf16_t* __restrict__ proj, const float* __restrict__ cw, const float* __restrict__ cb, float* __restrict__ xbc) {
    const size_t idx = (size_t)blockIdx.x * 256 + threadIdx.x;
    const int c = (int)(idx & 511); const int t = (int)(idx >> 9); const int l = t & (L - 1);
    float a = cb[c];
#pragma unroll
    for (int j = 0; j < 4; ++j) { const int ll = l - 3 + j; if (ll >= 0) a += cw[j * 512 + c] * bf2f(proj[(size_t)(t - 3 + j) * PLD + C_XBC + c]); }
    xbc[idx] = silu_f(a);
}

__global__ __launch_bounds__(64) void k_ssd_scan(const float* __restrict__ xbc, const float* __restrict__ dtraw, const float* __restrict__ dt_bias, const float* __restrict__ a_log,
                                                 const float* __restrict__ dskip, float* __restrict__ yraw) {
    __shared__ float Bs[32][64], Cs[32][64], xs[32][64], dts[32];
    const int b = blockIdx.x >> 2, h = blockIdx.x & 3, g = h >> 1, lane = threadIdx.x;
    const float A = -__expf(a_log[h]), bias = dt_bias[h], dsk = dskip[h];
    float st[64];
#pragma unroll
    for (int n = 0; n < 64; ++n) st[n] = 0.f;
    for (int t0 = 0; t0 < L; t0 += 32) {
        __syncthreads();
#pragma unroll 8
        for (int i = 0; i < 32; ++i) {
            const size_t t = (size_t)b * L + t0 + i;
            Bs[i][lane] = xbc[t * 512 + 256 + g * 64 + lane];
            Cs[i][lane] = xbc[t * 512 + 384 + g * 64 + lane];
            xs[i][lane] = xbc[t * 512 + h * 64 + lane];
        }
        if (lane < 32) { const float r = dtraw[((size_t)b * L + t0 + lane) * 4 + h] + bias; dts[lane] = r > 20.f ? r : log1pf(__expf(r)); }
        __syncthreads();
        for (int i = 0; i < 32; ++i) {
            const size_t t = (size_t)b * L + t0 + i;
            const float x = xs[i][lane];
            const float dt = dts[i], dA = __expf(dt * A), xd = x * dt;
            float y = 0.f;
#pragma unroll
            for (int n = 0; n < 64; ++n) { st[n] = dA * st[n] + xd * Bs[i][n]; y += Cs[i][n] * st[n]; }
            yraw[t * 256 + h * 64 + lane] = y + dsk * x;
        }
    }
}

__global__ __launch_bounds__(256) void k_ssd_post(const float* __restrict__ yraw, const bf16_t* __restrict__ proj, const float* __restrict__ nw, bf16_t* __restrict__ ycat) {
    const int lane = threadIdx.x & 63, wid = threadIdx.x >> 6;
    const size_t t = (size_t)blockIdx.x * 4 + wid;
    float gv[4]; float ss = 0.f;
#pragma unroll
    for (int j = 0; j < 4; ++j) { const int c = lane * 4 + j; const float zz = bf2f(proj[t * PLD + C_SZ + c]); gv[j] = yraw[t * 256 + c] * silu_f(zz); ss += gv[j] * gv[j]; }
#pragma unroll
    for (int o = 1; o < 32; o <<= 1) ss += __shfl_xor(ss, o);
    const float r = rsqrtf(ss * (1.f / 128.f) + RMS_EPS);
#pragma unroll
    for (int j = 0; j < 4; ++j) { const int c = lane * 4 + j; ycat[t * D + c] = f2bf(gv[j] * r * nw[c]); }
}

__global__ __launch_bounds__(64) void k_hgrn_scan(const bf16_t* __restrict__ proj, const float* __restrict__ lb_logits, int layer, const float* __restrict__ nw, bf16_t* __restrict__ ycat) {
    __shared__ float qs[32][64], fs[32][64], is_[32][64], gs[32][64];
    const int b = blockIdx.x >> 2, h = blockIdx.x & 3, lane = threadIdx.x;
    float lb = 0.f;
    if (layer == 1) { const float l0 = lb_logits[h * 64 + lane], l1 = lb_logits[256 + h * 64 + lane]; const float mx = fmaxf(l0, l1); const float e0 = __expf(l0 - mx), e1 = __expf(l1 - mx); lb = e1 / (e0 + e1); }
    const float nwv = nw[h * 64 + lane];
    float S[64];
#pragma unroll
    for (int d = 0; d < 64; ++d) S[d] = 0.f;
    for (int t0 = 0; t0 < L; t0 += 32) {
        __syncthreads();
#pragma unroll 8
        for (int i = 0; i < 32; ++i) {
            const size_t t = (size_t)b * L + t0 + i;
            qs[i][lane] = bf2f(proj[t * PLD + C_HQ + h * 64 + lane]);
            const float fr = bf2f(proj[t * PLD + C_HF + h * 64 + lane]);
            fs[i][lane] = lb + (1.f - lb) * sigmoid_f(fr);
            is_[i][lane] = bf2f(proj[t * PLD + C_HI + h * 64 + lane]);
            gs[i][lane] = bf2f(proj[t * PLD + C_HG + h * 64 + lane]);
        }
        __syncthreads();
        for (int i = 0; i < 32; ++i) {
            const size_t t = (size_t)b * L + t0 + i;
            const float iv = is_[i][lane];
            float o = 0.f;
#pragma unroll
            for (int d = 0; d < 64; ++d) { const float f = fs[i][d]; S[d] = f * S[d] + (1.f - f) * iv; o += qs[i][d] * S[d]; }
            const float ms = wave_sum(o * o) * (1.f / 64.f);
            const float gate = gs[i][lane];
            ycat[t * D + 256 + h * 64 + lane] = f2bf(o * rsqrtf(ms + RMS_EPS) * nwv * silu_f(gate));
        }
    }
}

__global__ __launch_bounds__(64) void k_ret_scan(const bf16_t* __restrict__ proj, bf16_t* __restrict__ ycat) {
    __shared__ float qs[32][64], ks[32][64], vs[32][64], gs[32][64];
    const int b = blockIdx.x >> 2, h = blockIdx.x & 3, lane = threadIdx.x;
    const float gam = 1.f - exp2f(-5.f - (float)h);
    float S[64];
#pragma unroll
    for (int d = 0; d < 64; ++d) S[d] = 0.f;
    for (int t0 = 0; t0 < L; t0 += 32) {
        __syncthreads();
#pragma unroll 8
        for (int i = 0; i < 32; ++i) {
            const size_t t = (size_t)b * L + t0 + i;
            qs[i][lane] = bf2f(proj[t * PLD + C_RQ + h * 64 + lane]);
            ks[i][lane] = bf2f(proj[t * PLD + C_RK + h * 64 + lane]) * 0.125f;
            vs[i][lane] = bf2f(proj[t * PLD + C_RV + h * 64 + lane]);
            gs[i][lane] = bf2f(proj[t * PLD + C_RG + h * 64 + lane]);
        }
        __syncthreads();
        for (int i = 0; i < 32; ++i) {
            const size_t t = (size_t)b * L + t0 + i;
            const float vv = vs[i][lane];
            float y = 0.f;
#pragma unroll
            for (int d = 0; d < 64; ++d) { S[d] = gam * S[d] + ks[i][d] * vv; y += qs[i][d] * S[d]; }
            const float mu = wave_sum(y) * (1.f / 64.f);
            const float dv = y - mu;
            const float var = wave_sum(dv * dv) * (1.f / 64.f);
            const float gate = gs[i][lane];
            ycat[t * D + 512 + h * 64 + lane] = f2bf(dv * rsqrtf(var + LN_EPS) * silu_f(gate));
        }
    }
}

__global__ __launch_bounds__(64) void k_moba_kmean(const bf16_t* __restrict__ proj, float* __restrict__ kmean) {
    const int n = blockIdx.x & 31, h = (blockIdx.x >> 5) & 3, b = blockIdx.x >> 7, lane = threadIdx.x;
    float s = 0.f;
    for (int j = 0; j < 256; ++j) s += bf2f(proj[((size_t)b * L + n * 256 + j) * PLD + C_MK + h * 64 + lane]);
    kmean[(size_t)blockIdx.x * 64 + lane] = s * (1.f / 256.f);
}

__global__ __launch_bounds__(256) void k_moba_naive(const bf16_t* __restrict__ proj, const float* __restrict__ kmean, bf16_t* __restrict__ ycat) {
    __shared__ float ps[4][1024];
    __shared__ float qs[4][64];
    const int lane = threadIdx.x & 63, wid = threadIdx.x >> 6;
    const int id = blockIdx.x * 4 + wid; const int t = id >> 2, h = id & 3;
    const int b = t / L, l = t % L, own = l >> 8;
    const float slope = exp2f(-2.f * (float)(h + 1));
    qs[wid][lane] = bf2f(proj[(size_t)t * PLD + C_MQ + h * 64 + lane]) * 0.125f;
    __syncthreads();
    float g = -INFINITY;
    if (lane < own) { const float* km = kmean + ((size_t)(b * 4 + h) * 32 + lane) * 64; float s = 0.f; for (int d = 0; d < 64; ++d) s += qs[wid][d] * km[d]; g = s; }
    int sel[3]; int nvalid = 0;
#pragma unroll
    for (int r = 0; r < 3; ++r) {
        const float mv = wave_max(g);
        const unsigned long long mask = __ballot(g == mv);
        const int idx = __ffsll((long long)mask) - 1;
        sel[r] = idx;
        if (mv > -INFINITY) nvalid = r + 1;
        if (lane == idx) g = -INFINITY;
    }
    float sc[4][4];
    float mx = -INFINITY;
#pragma unroll
    for (int r = 0; r < 4; ++r) {
        const bool valid = (r < 3) ? (r < nvalid) : true;
        const int blk = (r < 3) ? sel[r] : own;
#pragma unroll
        for (int i = 0; i < 4; ++i) {
            const int j = lane + 64 * i; const int spos = blk * 256 + j; const int rel = l - spos;
            float s = -INFINITY;
            if (valid && rel >= 0) {
                const uint4* kr = (const uint4*)(proj + ((size_t)b * L + spos) * PLD + C_MK + h * 64);
                float dsum = 0.f;
#pragma unroll
                for (int d8 = 0; d8 < 8; ++d8) {
                    const uint4 kv = kr[d8]; const float* qq = &qs[wid][d8 * 8];
                    dsum += qq[0] * __uint_as_float(kv.x << 16) + qq[1] * __uint_as_float(kv.x & 0xffff0000u)
                          + qq[2] * __uint_as_float(kv.y << 16) + qq[3] * __uint_as_float(kv.y & 0xffff0000u)
                          + qq[4] * __uint_as_float(kv.z << 16) + qq[5] * __uint_as_float(kv.z & 0xffff0000u)
                          + qq[6] * __uint_as_float(kv.w << 16) + qq[7] * __uint_as_float(kv.w & 0xffff0000u);
                }
                s = dsum - slope * (float)rel;
            }
            sc[r][i] = s; mx = fmaxf(mx, s);
        }
    }
    mx = wave_max(mx);
    float sum = 0.f;
#pragma unroll
    for (int r = 0; r < 4; ++r)
#pragma unroll
        for (int i = 0; i < 4; ++i) { const float p = __expf(sc[r][i] - mx); sum += p; ps[wid][r * 256 + lane + 64 * i] = p; }
    sum = wave_sum(sum);
    __syncthreads();
    float o = 0.f;
#pragma unroll
    for (int r = 0; r < 4; ++r) {
        const bool valid = (r < 3) ? (r < nvalid) : true;
        if (!valid) continue;
        const int blk = (r < 3) ? sel[r] : own;
        const int cnt = (r < 3) ? 256 : ((l & 255) + 1);
        const bf16_t* vr = proj + ((size_t)b * L + blk * 256) * PLD + C_MV + h * 64 + lane;
#pragma unroll 8
        for (int j = 0; j < cnt; ++j) o += ps[wid][r * 256 + j] * bf2f(vr[(size_t)j * PLD]);
    }
    o /= sum;
    const float gate = bf2f(proj[(size_t)t * PLD + C_MG + h * 64 + lane]);
    ycat[(size_t)t * D + 768 + h * 64 + lane] = f2bf(o * silu_f(gate));
}

extern "C" void kernel_launch(void* const* d_in, const int* in_sizes, int n_in, void* d_out, int out_size, void* d_ws, size_t ws_size, hipStream_t stream) {
    const float* x = (const float*)d_in[0];
    const float* emb_g = (const float*)d_in[1];
    const float* emb_b = (const float*)d_in[2];
    const float* w_in = (const float*)d_in[3];
    const float* conv_w = (const float*)d_in[4];
    const float* conv_b = (const float*)d_in[5];
    const float* dt_bias = (const float*)d_in[6];
    const float* a_log = (const float*)d_in[7];
    const float* ssd_d = (const float*)d_in[8];
    const float* ssd_nw = (const float*)d_in[9];
    const float* lb_logits = (const float*)d_in[10];
    const float* hgrn_nw = (const float*)d_in[11];
    const float* w_out = (const float*)d_in[12];
    const float* ln_g = (const float*)d_in[13];
    const float* ln_b = (const float*)d_in[14];
    float* h = (float*)d_out;
    char* ws = (char*)d_ws;
    bf16_t* proj = (bf16_t*)ws;                       ws += (size_t)M * PLD * 2;
    bf16_t* ycat = (bf16_t*)ws;                       ws += (size_t)M * D * 2;
    float* z = (float*)ws;                            ws += (size_t)M * D * 4;
    float* dtraw = (float*)ws;                        ws += (size_t)M * 4 * 4;
    float* kmean = (float*)ws;                        ws += (size_t)NB * 4 * 32 * 64 * 4;
    float* xbc = z;
    float* yraw = z + (size_t)M * 512;

    k_ln_rows<<<M / 4, 256, 0, stream>>>(x, emb_g, emb_b, h);
    for (int l = 0; l < 2; ++l) {
        k_gemm_naive<0><<<dim3((NIN + 63) / 64, M / 64), 256, 0, stream>>>(h, w_in + (size_t)l * D * NIN, NIN, D, proj, dtraw, nullptr, nullptr);
        k_conv<<<(M * 512) / 256, 256, 0, stream>>>(proj, conv_w + l * 4 * 512, conv_b + l * 512, xbc);
        k_ssd_scan<<<16, 64, 0, stream>>>(xbc, dtraw, dt_bias + l * 4, a_log + l * 4, ssd_d + l * 4, yraw);
        k_ssd_post<<<M / 4, 256, 0, stream>>>(yraw, proj, ssd_nw + l * 256, ycat);
        k_hgrn_scan<<<16, 64, 0, stream>>>(proj, lb_logits, l, hgrn_nw + l * 256, ycat);
        k_ret_scan<<<16, 64, 0, stream>>>(proj, ycat);
        k_moba_kmean<<<NB * 4 * 32, 64, 0, stream>>>(proj, kmean);
        k_moba_naive<<<M, 256, 0, stream>>>(proj, kmean, ycat);
        k_gemm_naive<1><<<dim3(D / 64, M / 64), 256, 0, stream>>>(ycat, w_out + (size_t)l * D * D, D, D, nullptr, nullptr, h, z);
        k_ln_rows<<<M / 4, 256, 0, stream>>>(z, ln_g + l * D, ln_b + l * D, h);
    }
}
```

```cpp
#include <hip/hip_runtime.h>
#include <cstdio>
#include <cstdint>
#include <math.h>

namespace pg8 {
#define PG8_LAS __attribute__((address_space(3)))
typedef unsigned short bf16_t;
typedef short bf16x8 __attribute__((ext_vector_type(8)));
typedef float f32x4 __attribute__((ext_vector_type(4)));
typedef unsigned u32x4 __attribute__((ext_vector_type(4)));
constexpr int BM = 256, BK = 64, HALF = 128, HTB = HALF * BK * 2  , STAGE_BYTES = 8 * HTB, NXCD = 8, WGM = 8;

__host__ __device__ __forceinline__ int lds_byte(int r, int c) { const int st = (r >> 4) * 2 + (c >> 5), rr = r & 15, cc = c & 31, ob = rr * 64 + cc * 2; return st * 1024 + (ob ^ (((ob >> 9) & 1) << 5)); }
__host__ __device__ __forceinline__ void stage_rc(int b, int& R, int& C) { const int st = b / 1024, sb = b % 1024, swz = sb ^ (((sb >> 9) & 1) << 5); R = (st >> 1) * 16 + swz / 64; C = (st & 1) * 32 + (swz % 64) / 2; }
__host__ __device__ __forceinline__ int perm32(int rho) { const int n = rho >> 4, i = rho & 15; return 8 * (i >> 2) + 4 * n + (i & 3); }

struct Unit { int pm, pn; };
struct Gemm { const bf16_t* A; const bf16_t* Bt; int M, N, K; };

struct StaticOrder {
    int nM, nN, nwg, G, c;
    __host__ __device__ void init(int M, int N, int G_, int c_) { nM = M / BM; nN = N / BM; nwg = nM * nN; G = G_; c = c_; }
    __host__ __device__ bool next(int i, Unit& u) const {
        const long L = (long)i * G + c; if (L >= nwg) return false;
        int wgid = (int)L; { const int q = nwg / NXCD, r = nwg % NXCD, xcd = wgid % NXCD, off = wgid / NXCD; wgid = (xcd < r ? xcd * (q + 1) : r * (q + 1) + (xcd - r) * q) + off; }
        const int nig = WGM * nN, gid = wgid / nig, fm = gid * WGM, gsz = (nM - fm) < WGM ? (nM - fm) : WGM;
        u.pm = fm + ((wgid % nig) % gsz); u.pn = (wgid % nig) / gsz; return true;
    }
    __device__ __forceinline__ void a_ready(const Unit&) const {}
    __device__ __forceinline__ void done(const Unit&) const {}
};

__device__ __forceinline__ unsigned cvt_pk_bf16(float lo, float hi) { unsigned r; asm volatile("v_cvt_pk_bf16_f32 %0, %1, %2" : "=v"(r) : "v"(lo), "v"(hi)); return r; }

typedef float f32x2 __attribute__((ext_vector_type(2)));
constexpr int PLD_ = 3840;
struct EpiProj {
    static constexpr bool PERM = true, AFTER_DRAIN = false;
    bf16_t* O; float qscale;
    __device__ __forceinline__ void operator()(const f32x4 (&acc)[2][2][4][2], const Unit& u, int wr, int wc, int fr, int fq) const {
        const int row0 = u.pm * BM + wr * 64 + fr; const int colt = u.pn * BM;
        const float sc = (u.pn == 11) ? qscale : 1.f;
        const int col0 = colt + wc * 32 + 8 * fq;
#pragma unroll
        for (int ai = 0; ai < 2; ++ai)
#pragma unroll
            for (int m = 0; m < 4; ++m) { bf16_t* rowp = O + (size_t)(row0 + ai * HALF + m * 16) * PLD_ + col0;
#pragma unroll
                for (int bj = 0; bj < 2; ++bj) { f32x4 v0 = acc[ai][bj][m][0] * sc, v1 = acc[ai][bj][m][1] * sc;
                    u32x4 w; w.x = cvt_pk_bf16(v0[0], v0[1]); w.y = cvt_pk_bf16(v0[2], v0[3]); w.z = cvt_pk_bf16(v1[0], v1[1]); w.w = cvt_pk_bf16(v1[2], v1[3]);
                    *(u32x4*)(rowp + bj * HALF) = w; } }
    }
};
struct EpiZ {
    static constexpr bool PERM = false, AFTER_DRAIN = false;
    float* Z; const float* Hres; float alpha;
    __device__ __forceinline__ void operator()(const f32x4 (&acc)[2][2][4][2], const Unit& u, int wr, int wc, int fr, int fq) const {
        const int row0 = u.pm * BM + wr * 64 + fr, col0 = u.pn * BM + wc * 32 + 4 * fq;
#pragma unroll
        for (int ai = 0; ai < 2; ++ai)
#pragma unroll
            for (int m = 0; m < 4; ++m) { const size_t ro = (size_t)(row0 + ai * HALF + m * 16) * 1024 + col0;
#pragma unroll
                for (int bj = 0; bj < 2; ++bj)
#pragma unroll
                    for (int n = 0; n < 2; ++n) { const f32x4 hv = *(const f32x4*)(Hres + ro + bj * HALF + n * 16);
                        *(f32x4*)(Z + ro + bj * HALF + n * 16) = hv * alpha + acc[ai][bj][m][n]; } }
    }
};
template <class Epi, class Sched, bool ALIGN_EPI = false, bool SP2 = false>
__device__ __forceinline__ void gemm_phase(PG8_LAS unsigned char* lds, const Gemm g, const Sched& S, const Epi& E) {
    const int tid = threadIdx.x, wid = __builtin_amdgcn_readfirstlane(tid >> 6), lane = tid & 63, wr = wid >> 2, wc = wid & 3, fr = lane & 15, fq = lane >> 4;
    const int K = g.K, nt = K / BK;
    unsigned voffA[2], voffB[2];
#pragma unroll
    for (int i = 0; i < 2; ++i) { int R, C; stage_rc(tid * 16 + i * 8192, R, C); const int Rb = Epi::PERM ? ((R & ~31) + perm32(R & 31)) : R;
        voffA[i] = (unsigned)(R * K + C) * 2u; voffB[i] = (unsigned)(Rb * K + C) * 2u; }
    const size_t kstep = (size_t)(BK * 2);
    const size_t hstep = (size_t)HALF * K * 2;
    const size_t tstep = 2 * hstep;
    const unsigned ldsw = (unsigned)wid * 1024u;
    const int aoff = lds_byte(wr * 64 + fr, fq * 8), boff = lds_byte(wc * 32 + fr, fq * 8);
#define PG8_SA(b, h) (((b) * 2 + (h)) * HTB)
#define PG8_SB(b, h) ((4 + (b) * 2 + (h)) * HTB)
#define PG8_STAGE(bufoff, gbase, voff) do { _Pragma("unroll") for (int _i = 0; _i < 2; ++_i) \
        __builtin_amdgcn_global_load_lds((const unsigned*)((const char*)(gbase) + (voff)[_i]), (PG8_LAS unsigned*)(lds + (bufoff) + ldsw + _i * 8192), 16, 0, 0); } while (0)
#define PG8_LDA(dst, b, h) do { _Pragma("unroll") for (int m = 0; m < 4; ++m) _Pragma("unroll") for (int k = 0; k < 2; ++k) dst[m][k] = *(const PG8_LAS bf16x8*)(lds + PG8_SA(b, h) + aoff + m * 2048 + k * 1024); } while (0)
#define PG8_LDB(dst, b, h) do { _Pragma("unroll") for (int n = 0; n < 2; ++n) _Pragma("unroll") for (int k = 0; k < 2; ++k) dst[n][k] = *(const PG8_LAS bf16x8*)(lds + PG8_SB(b, h) + boff + n * 2048 + k * 1024); } while (0)
#define PG8_MMA(ai, bj, At, Bt) do { __builtin_amdgcn_s_setprio(1); _Pragma("unroll") for (int m = 0; m < 4; ++m) _Pragma("unroll") for (int n = 0; n < 2; ++n) _Pragma("unroll") for (int k = 0; k < 2; ++k) \
        acc[ai][bj][m][n] = __builtin_amdgcn_mfma_f32_16x16x32_bf16(Bt[n][k], At[m][k], acc[ai][bj][m][n], 0, 0, 0); __builtin_amdgcn_s_setprio(0); } while (0)
#define PG8_WAIT_V(n) asm volatile("s_waitcnt vmcnt(" #n ")" ::: "memory")
#define PG8_WAIT_L(n) asm volatile("s_waitcnt lgkmcnt(" #n ")" ::: "memory")
#define PG8_BAR __builtin_amdgcn_s_barrier()
#define PG8_SCHED __builtin_amdgcn_sched_barrier(0)
    Unit cur, nxt; int ui = 0;
    if (!S.next(0, cur)) return;
    f32x4 acc[2][2][4][2];
#pragma unroll
    for (int a = 0; a < 2; ++a)
#pragma unroll
        for (int b = 0; b < 2; ++b)
#pragma unroll
            for (int m = 0; m < 4; ++m)
#pragma unroll
                for (int n = 0; n < 2; ++n) acc[a][b][m][n] = (f32x4){0.f, 0.f, 0.f, 0.f};
    bf16x8 At[4][2], B0[2][2], B1[2][2];
    const char* cA = (const char*)g.A + (size_t)cur.pm * tstep; const char* cB = (const char*)g.Bt + (size_t)cur.pn * tstep;
    S.a_ready(cur);
    if constexpr (SP2) {
        PG8_STAGE(PG8_SB(0, 0), cB, voffB); PG8_STAGE(PG8_SB(0, 1), cB + hstep, voffB); PG8_STAGE(PG8_SA(0, 0), cA, voffA); PG8_STAGE(PG8_SA(0, 1), cA + hstep, voffA);
        if (wr == 1) PG8_BAR;
        PG8_WAIT_V(2); PG8_BAR;
        PG8_STAGE(PG8_SB(1, 0), cB + kstep, voffB); PG8_STAGE(PG8_SA(1, 0), cA + kstep, voffA); PG8_STAGE(PG8_SB(1, 1), cB + hstep + kstep, voffB);
        PG8_WAIT_V(6); PG8_BAR;
    } else {
        PG8_STAGE(PG8_SB(0, 0), cB, voffB); PG8_STAGE(PG8_SA(0, 0), cA, voffA); PG8_STAGE(PG8_SB(0, 1), cB + hstep, voffB); PG8_STAGE(PG8_SA(0, 1), cA + hstep, voffA);
        if (wr == 1) PG8_BAR;
        PG8_WAIT_V(4); PG8_BAR;
        PG8_STAGE(PG8_SB(1, 0), cB + kstep, voffB); PG8_STAGE(PG8_SA(1, 0), cA + kstep, voffA); PG8_STAGE(PG8_SB(1, 1), cB + hstep + kstep, voffB);
        PG8_WAIT_V(6); PG8_BAR;
    }
    for (;;) {
        const bool has_next = S.next(ui + 1, nxt);
        const char* nA = has_next ? (const char*)g.A + (size_t)nxt.pm * tstep : cA; const char* nB = has_next ? (const char*)g.Bt + (size_t)nxt.pn * tstep : cB;
        for (int t = 0; t < nt; t += 2) {
            const bool last = (t == nt - 2);
            const char* a1 = cA + (size_t)(t + 1) * kstep;
            const char* a2 = last ? nA : cA + (size_t)(t + 2) * kstep; const char* b2 = last ? nB : cB + (size_t)(t + 2) * kstep;
            const char* a3 = a2 + kstep; const char* b3 = b2 + kstep;
            if (last && has_next) S.a_ready(nxt);
            if constexpr (SP2) {
            PG8_LDB(B0, 0, 0); PG8_LDB(B1, 0, 1); PG8_SCHED; PG8_LDA(At, 0, 0); PG8_STAGE(PG8_SA(1, 1), a1 + hstep, voffA);
            PG8_WAIT_V(8); PG8_WAIT_L(0); PG8_BAR; PG8_MMA(0, 0, At, B0); PG8_MMA(0, 1, At, B1); PG8_BAR; PG8_SCHED;
            PG8_LDA(At, 0, 1); PG8_STAGE(PG8_SB(0, 0), b2, voffB); PG8_STAGE(PG8_SB(0, 1), b2 + hstep, voffB); PG8_STAGE(PG8_SA(0, 0), a2, voffA);
            PG8_WAIT_V(8); PG8_WAIT_L(0); PG8_BAR; PG8_MMA(1, 0, At, B0); PG8_MMA(1, 1, At, B1); PG8_BAR; PG8_SCHED;
            PG8_LDB(B0, 1, 0); PG8_LDB(B1, 1, 1); PG8_SCHED; PG8_LDA(At, 1, 0); PG8_STAGE(PG8_SA(0, 1), a2 + hstep, voffA);
            PG8_WAIT_V(8); PG8_WAIT_L(0); PG8_BAR; PG8_MMA(0, 0, At, B0); PG8_MMA(0, 1, At, B1); PG8_BAR; PG8_SCHED;
            PG8_LDA(At, 1, 1); PG8_STAGE(PG8_SB(1, 0), b3, voffB); PG8_STAGE(PG8_SB(1, 1), b3 + hstep, voffB); PG8_STAGE(PG8_SA(1, 0), a3, voffA);
            PG8_WAIT_V(8); PG8_WAIT_L(0); PG8_BAR; PG8_MMA(1, 0, At, B0); PG8_MMA(1, 1, At, B1); PG8_BAR; PG8_SCHED;
            } else {
            PG8_LDB(B0, 0, 0); PG8_SCHED; PG8_LDA(At, 0, 0); PG8_STAGE(PG8_SA(1, 1), a1 + hstep, voffA);
            PG8_WAIT_L(8); PG8_BAR; PG8_WAIT_L(0); PG8_MMA(0, 0, At, B0); PG8_BAR; PG8_SCHED;
            PG8_LDB(B1, 0, 1); PG8_STAGE(PG8_SB(0, 0), b2, voffB);
            PG8_BAR; PG8_WAIT_L(0); PG8_MMA(0, 1, At, B1); PG8_BAR;
            PG8_LDA(At, 0, 1); PG8_STAGE(PG8_SA(0, 0), a2, voffA);
            PG8_BAR; PG8_WAIT_L(0); PG8_MMA(1, 0, At, B0); PG8_BAR; PG8_SCHED;
            PG8_STAGE(PG8_SB(0, 1), b2 + hstep, voffB);
            PG8_WAIT_V(6); PG8_BAR; PG8_MMA(1, 1, At, B1); PG8_BAR;
            PG8_LDB(B0, 1, 0); PG8_SCHED; PG8_LDA(At, 1, 0); PG8_STAGE(PG8_SA(0, 1), a2 + hstep, voffA);
            PG8_WAIT_L(8); PG8_BAR; PG8_WAIT_L(0); PG8_MMA(0, 0, At, B0); PG8_BAR; PG8_SCHED;
            PG8_LDB(B1, 1, 1); PG8_STAGE(PG8_SB(1, 0), b3, voffB);
            PG8_BAR; PG8_WAIT_L(0); PG8_MMA(0, 1, At, B1); PG8_BAR;
            PG8_LDA(At, 1, 1); PG8_STAGE(PG8_SA(1, 0), a3, voffA);
            PG8_BAR; PG8_WAIT_L(0); PG8_MMA(1, 0, At, B0); PG8_BAR; PG8_SCHED;
            PG8_STAGE(PG8_SB(1, 1), b3 + hstep, voffB);
            PG8_WAIT_V(6); PG8_BAR; PG8_MMA(1, 1, At, B1); PG8_BAR;
            }
        }
        if constexpr (ALIGN_EPI) { if (wr == 0) PG8_BAR; }
        if constexpr (!Epi::AFTER_DRAIN) { E(acc, cur, wr, wc, fr, fq); S.done(cur); }
        if (!has_next) break;
#pragma unroll
        for (int a = 0; a < 2; ++a)
#pragma unroll
            for (int b = 0; b < 2; ++b)
#pragma unroll
                for (int m = 0; m < 4; ++m)
#pragma unroll
                    for (int n = 0; n < 2; ++n) acc[a][b][m][n] = (f32x4){0.f, 0.f, 0.f, 0.f};
        cur = nxt; cA = nA; cB = nB; ++ui;
        if constexpr (ALIGN_EPI) { if (wr == 1) PG8_BAR; }
    }
    PG8_WAIT_V(0);
    if constexpr (!ALIGN_EPI) { if (wr == 0) PG8_BAR; }
    PG8_BAR;
    if constexpr (Epi::AFTER_DRAIN) { E.fused(acc, cur, wr, wc, fr, fq, lds, wid, lane); S.done(cur); }
#undef PG8_SA
#undef PG8_SB
#undef PG8_STAGE
#undef PG8_LDA
#undef PG8_LDB
#undef PG8_MMA
#undef PG8_WAIT_V
#undef PG8_WAIT_L
#undef PG8_BAR
#undef PG8_SCHED
}
}


typedef unsigned short bf16_t;
__device__ __forceinline__ float bf2f(bf16_t b) { return __uint_as_float(((unsigned)b) << 16); }
__device__ __forceinline__ bf16_t f2bf(float f) { unsigned u = __float_as_uint(f); u += 0x7fffu + ((u >> 16) & 1u); return (bf16_t)(u >> 16); }
__device__ __forceinline__ unsigned pk2(float lo, float hi) { return (unsigned)f2bf(lo) | ((unsigned)f2bf(hi) << 16); }
__device__ __forceinline__ float silu_f(float x) { return x / (1.f + __expf(-x)); }
__device__ __forceinline__ float sigmoid_f(float x) { return 1.f / (1.f + __expf(-x)); }
__device__ __forceinline__ float wave_sum(float v) {
#pragma unroll
    for (int o = 1; o < 64; o <<= 1) v += __shfl_xor(v, o);
    return v;
}
__device__ __forceinline__ float wave_max(float v) {
#pragma unroll
    for (int o = 1; o < 64; o <<= 1) v = fmaxf(v, __shfl_xor(v, o));
    return v;
}

constexpr int NB = 4, L = 8192, M = NB * L, D = 1024, NIN = 3844, PLD = 3840;
constexpr int C_SZ = 0, C_XBC = 256, C_HQ = 768, C_HF = 1024, C_HI = 1280, C_HG = 1536, C_RQ = 1792, C_RK = 2048, C_RV = 2304, C_RG = 2560,
              C_MQ = 2816, C_MK = 3072, C_MV = 3328, C_MG = 3584;
constexpr float LN_EPS = 1e-5f, RMS_EPS = 1e-6f;
#define ALPHA 1.4142135623730951f
constexpr float QC2 = 0.125f * 1.4426950408889634f;


#include <hip/hip_bf16.h>
#include <cmath>
namespace attn_body {
using bf16=__hip_bfloat16;
using bf16x8=__attribute__((ext_vector_type(8)))short;
using s16x4=__attribute__((ext_vector_type(4)))short;
using f32x16=__attribute__((ext_vector_type(16)))float;
using u32x4=__attribute__((ext_vector_type(4)))unsigned;
constexpr int BATCH=4,NHEAD=4,SEQ=8192,D=64,DM=3840,DMO=1024,OCOL=768;
constexpr int NW=8,QBLK=32,QB=QBLK*NW,KVBLK=64,NQB=SEQ/QB;
constexpr int ATTN_PITCH=DM, ATTN_UNIT_ROWS=QB;
__device__ __forceinline__ int crow(int r,int hi){return (r&3)+8*(r>>2)+4*hi;}
#define SBAR() __builtin_amdgcn_sched_barrier(0)
__device__ __forceinline__ void cmask(f32x16&p0,f32x16&p1,int jb,int qrel,int hi){
  const float NEG=-INFINITY; int kb=64*jb+4*hi;
  #pragma unroll
  for(int r=0;r<16;++r){int kv=kb+(r&3)+8*(r>>2); if(kv>qrel)p0[r]=NEG; if(kv+32>qrel)p1[r]=NEG;}
}

constexpr int NSLOT=3, SLOTB=8192;
constexpr int LDS_K=0, LDS_V=NSLOT*SLOTB, LDS_WS=2*NSLOT*SLOTB, LDS_OST=LDS_WS+NW*64*4, LDS_BYTES=LDS_OST+NW*4096;
constexpr float C2=0.125f*1.4426950408889634f;
__device__ __forceinline__ void glds16(const void*gsrc,unsigned lds_dst){unsigned keep;
  asm volatile("s_mov_b32 %0, m0\n\ts_mov_b32 m0, %2\n\ts_nop 0\n\tglobal_load_lds_dwordx4 %1, off\n\ts_mov_b32 m0, %0":"=&s"(keep):"v"(gsrc),"s"(lds_dst):"memory");}
__device__ __forceinline__ float max3f(float a,float b,float c){float r;asm("v_max3_f32 %0, %1, %2, %3":"=v"(r):"v"(a),"v"(b),"v"(c));return r;}
__device__ __forceinline__ float max2f(float a,float b){float r;asm("v_max_f32_e32 %0, %1, %2":"=v"(r):"v"(a),"v"(b));return r;}
__device__ __forceinline__ float fadd_s(float a,float b){float r;asm("v_add_f32_e32 %0, %1, %2":"=v"(r):"v"(a),"v"(b));return r;}
__device__ __forceinline__ float fsub_s(float a,float b){float r;asm("v_sub_f32_e32 %0, %1, %2":"=v"(r):"v"(a),"v"(b));return r;}
typedef float f32x2_t __attribute__((ext_vector_type(2))); typedef __bf16 bf16x2_t __attribute__((ext_vector_type(2)));
__device__ __forceinline__ unsigned cvtpk_s(float lo,float hi){f32x2_t v={lo,hi};bf16x2_t b=__builtin_convertvector(v,bf16x2_t);return __builtin_bit_cast(unsigned,b);}
#define WAIT_BAR(N) asm volatile("s_waitcnt vmcnt(" #N ") lgkmcnt(0)\n\ts_barrier":::"memory")

__device__ __forceinline__ void qkt(f32x16&p0,f32x16&p1,const char*Kslot,const bf16x8*qr,int r32,int hi){
  const char*kb=Kslot+hi*1024+r32*16;
  #pragma unroll
  for(int d0=0;d0<4;++d0){
    const bf16x8 b0=*reinterpret_cast<const bf16x8*>(kb+d0*2048);
    const bf16x8 b1=*reinterpret_cast<const bf16x8*>(kb+d0*2048+512);
    p0=__builtin_amdgcn_mfma_f32_32x32x16_bf16(b0,qr[d0],p0,0,0,0);p1=__builtin_amdgcn_mfma_f32_32x32x16_bf16(b1,qr[d0],p1,0,0,0);}
}
typedef __attribute__((address_space(3))) const char* lds_cptr;
typedef short v4i16_t __attribute__((ext_vector_type(4)));
__device__ __forceinline__ void kload8(bf16x8*kf,lds_cptr kp){
  kf[0]=*(const __attribute__((address_space(3))) bf16x8*)(kp);      kf[1]=*(const __attribute__((address_space(3))) bf16x8*)(kp+512);
  kf[2]=*(const __attribute__((address_space(3))) bf16x8*)(kp+2048); kf[3]=*(const __attribute__((address_space(3))) bf16x8*)(kp+2560);
  kf[4]=*(const __attribute__((address_space(3))) bf16x8*)(kp+4096); kf[5]=*(const __attribute__((address_space(3))) bf16x8*)(kp+4608);
  kf[6]=*(const __attribute__((address_space(3))) bf16x8*)(kp+6144); kf[7]=*(const __attribute__((address_space(3))) bf16x8*)(kp+6656);
}
__device__ __forceinline__ void kload2(bf16x8*kf,lds_cptr kp,int j){ kf[2*j]=*(const __attribute__((address_space(3))) bf16x8*)(kp+j*2048); kf[2*j+1]=*(const __attribute__((address_space(3))) bf16x8*)(kp+j*2048+512); }
__device__ __forceinline__ s16x4 vtr(lds_cptr p){ return __builtin_bit_cast(s16x4,__builtin_amdgcn_ds_read_tr16_b64_v4i16((__attribute__((address_space(3))) v4i16_t*)p)); }
__device__ __forceinline__ float rowmax(const f32x16&p0,const f32x16&p1){
  float a=max3f(p0[0],p0[1],p1[0]),b=max3f(p0[2],p0[3],p1[1]);a=max3f(a,p1[2],p1[3]);
  #pragma unroll
  for(int r=4;r<16;r+=4){a=max3f(a,p0[r],p0[r+1]);b=max3f(b,p0[r+2],p0[r+3]);a=max3f(a,p1[r],p1[r+1]);b=max3f(b,p1[r+2],p1[r+3]);}
  const float m=max2f(a,b);
  auto rr=__builtin_amdgcn_permlane32_swap(__float_as_uint(m),__float_as_uint(m),false,false);
  return max2f(__uint_as_float(rr[0]),__uint_as_float(rr[1]));
}
__device__ __forceinline__ void pv(f32x16*o,int vb,bf16x8 pa0,bf16x8 pa1,bf16x8 pa2,bf16x8 pa3){
  #pragma unroll
  for(int d0=0;d0<2;++d0){s16x4 lo[4],hi[4];
    #pragma unroll
    for(int ks=0;ks<4;++ks){
      asm volatile("ds_read_b64_tr_b16 %0,%1 offset:%c2":"=&v"(lo[ks]):"v"(vb),"i"(d0*4096+ks*1024):"memory");
      asm volatile("ds_read_b64_tr_b16 %0,%1 offset:%c2":"=&v"(hi[ks]):"v"(vb),"i"(d0*4096+ks*1024+512):"memory");}
    asm volatile("s_waitcnt lgkmcnt(0)":::"memory");SBAR();
    #define PK(k) (bf16x8){lo[k][0],lo[k][1],lo[k][2],lo[k][3],hi[k][0],hi[k][1],hi[k][2],hi[k][3]}
    o[d0]=__builtin_amdgcn_mfma_f32_32x32x16_bf16(pa0,PK(0),o[d0],0,0,0);
    o[d0]=__builtin_amdgcn_mfma_f32_32x32x16_bf16(pa1,PK(1),o[d0],0,0,0);
    o[d0]=__builtin_amdgcn_mfma_f32_32x32x16_bf16(pa2,PK(2),o[d0],0,0,0);
    o[d0]=__builtin_amdgcn_mfma_f32_32x32x16_bf16(pa3,PK(3),o[d0],0,0,0);
    #undef PK
  }
}

#ifndef ATTN_STORE16
#define ATTN_STORE16(p,v) (*(u32x4*)(p)=(v))
#endif
template<int THRL> __device__ __forceinline__ void attn_unit(int b,int h,int qb,const bf16*Q,const bf16*__restrict__ K,const bf16*__restrict__ V,const bf16*G,bf16*O,const unsigned*SEL,char*shm){
  int tid_=threadIdx.x; asm volatile("":"+v"(tid_)); const int tid=tid_,lane=tid&63,r32=lane&31,hi=lane>>5; const int wid=__builtin_amdgcn_readfirstlane(tid>>6);
  const long rowbase=(long)b*SEQ; const int q0=qb*QB;
  const bf16*Qw=Q+(rowbase+q0+wid*QBLK)*DM+h*D;
  const bf16*Kh=K+rowbase*DM+h*D,*Vh=V+rowbase*DM+h*D;
  const unsigned lds0=(unsigned)(uintptr_t)shm;
  float*wsf=(float*)(shm+LDS_WS)+wid*64;
  const bf16*ksrc=Kh+(long)lane*DM+wid*8;
  const bf16*vsrc=Vh+(long)(16*(wid&3)+(lane>>2))*DM+(wid>>2)*32+(lane&3)*8;
  const unsigned kdst=lds0+LDS_K+wid*1024, vdst=lds0+LDS_V+wid*1024;
  #define DMA_K(t,slot) glds16(ksrc+(long)(t)*KVBLK*DM,(unsigned)__builtin_amdgcn_readfirstlane(kdst+(slot)))
  #define DMA_V(t,slot) glds16(vsrc+(long)(t)*KVBLK*DM,(unsigned)__builtin_amdgcn_readfirstlane(vdst+(slot)))
  const int vb0=(int)(lds0+LDS_V)+((lane>>4)&1)*32+(lane&3)*8+(4*hi+((lane&15)>>2))*64;
  const char*Kbase=shm+LDS_K; bf16x8 kf[8];
  const lds_cptr shm3=(lds_cptr)shm; const lds_cptr kp0=shm3+LDS_K+hi*1024+r32*16; const lds_cptr vp0=shm3+LDS_V+((lane>>4)&1)*32+(lane&3)*8+(4*hi+((lane&15)>>2))*64;
  const int NT=(q0+QB)/KVBLK;
  DMA_K(0,0);DMA_V(0,0);DMA_K(1,SLOTB);
  bf16x8 qr[4];
  #pragma unroll
  for(int d0=0;d0<4;++d0)qr[d0]=*reinterpret_cast<const bf16x8*>(&Qw[(long)r32*DM+d0*16+hi*8]);
  float mhat=0.f,l_reg=0.f;f32x16 o[2];o[0]=f32x16{};o[1]=f32x16{};
  const int qrel=wid*QBLK+r32; const int tq=q0+qrel;
  const float slope2=__uint_as_float(__builtin_amdgcn_readfirstlane(__float_as_uint(__builtin_amdgcn_exp2f(-2.f*(float)(h+1))*1.4426950408889634f)));
  const unsigned mask=SEL[((long)(b*NHEAD+h))*SEQ+tq];
  #define CINIT(C0,C1,t) do{ const int blk_=(t)>>2; const bool sel_=(blk_>=qb)||(((mask>>blk_)&1u)!=0u); \
    const float b0_=sel_?__builtin_fmaf(slope2,(float)(64*(t)+4*hi-tq),-mhat):-INFINITY; const float b1_=b0_+32.f*slope2; \
    _Pragma("unroll") for(int r=0;r<16;++r){ C0[r]=__builtin_fmaf(slope2,(float)((r&3)+8*(r>>2)),b0_); C1[r]=__builtin_fmaf(slope2,(float)((r&3)+8*(r>>2)),b1_);} }while(0)
  #define CMASK(P0,P1,t) do{int jb_=(t)-(NT-4); if(jb_>=0)cmask(P0,P1,jb_,qrel,hi);}while(0)
  bool resc=false;
  #define START(P0,P1) do{ const float rm=rowmax(P0,P1); resc=false; \
    { const float dl=(rm>-INFINITY)?rm:0.f; mhat=fadd_s(mhat,dl); \
      _Pragma("unroll") for(int r=0;r<16;++r){P0[r]=fsub_s(P0[r],dl);P1[r]=fsub_s(P1[r],dl);} } \
    _Pragma("unroll") for(int r=0;r<16;++r)P0[r]=__builtin_amdgcn_exp2f(P0[r]); }while(0)
  #define RESC() do{ if(resc){ asm volatile("s_waitcnt lgkmcnt(0)":::"memory"); \
      _Pragma("unroll") for(int d_=0;d_<2;++d_) _Pragma("unroll") for(int r=0;r<16;++r)o[d_][r]*=wsf[crow(r,hi)]; } }while(0)
  f32x16 pA0,pA1,pB0,pB1;
  int sl_prev=0,sl_cur=0,sl_next=SLOTB;
  #define ROT() do{sl_prev=sl_cur;sl_cur=sl_next;sl_next=(sl_next==(NSLOT-1)*SLOTB)?0:sl_next+SLOTB;}while(0)
  DMA_K(2,2*SLOTB);
  WAIT_BAR(3);
  CINIT(pA0,pA1,0); qkt(pA0,pA1,Kbase,qr,r32,hi);asm volatile("s_nop 15\n\ts_nop 7":"+v"(pA0),"+v"(pA1));CMASK(pA0,pA1,0);
  START(pA0,pA1);
  _Pragma("unroll") for(int r=0;r<16;++r)pA1[r]=__builtin_amdgcn_exp2f(pA1[r]);
  WAIT_BAR(0);
  DMA_K(3,0);DMA_V(1,SLOTB);
  ROT();
  kload8(kf,kp0+sl_cur);
  WAIT_BAR(2);
  s16x4 vlo[8],vhi[8]; u32x4 pw0,pw1,pw2,pw3;
  #define PKW(P,B) cvtpk_s(P[B],P[B+1])
  #define PAF(k) __builtin_bit_cast(bf16x8,pw##k)
  #define VFR(i) (bf16x8){vlo[i][0],vlo[i][1],vlo[i][2],vlo[i][3],vhi[i][0],vhi[i][1],vhi[i][2],vhi[i][3]}
  #define PIN(x) asm volatile("":"+v"(x))
  #define MX3(a,b,c) __builtin_fmaxf(__builtin_fmaxf((a),(b)),(c))
  #define GAPA(MF,A0,A1,A2,A3,W0,W1,PW) do{ MF; sacc+=A0; sacc+=A1; sacc+=A2; sacc+=A3; PIN(sacc); W0; W1; PIN(PW); SBAR(); }while(0)
  #define EX(v) __builtin_amdgcn_exp2f(v)
  #define GAPB(MF,X,B) do{ MF; X[B]=EX(X[B]); X[B+1]=EX(X[B+1]); X[B+2]=EX(X[B+2]); X[B+3]=EX(X[B+3]); PIN(X); SBAR(); }while(0)
  #define VRD(i) do{ vlo[i]=vtr(vp_+(((i)>>2)*4096+((i)&3)*1024)); vhi[i]=vtr(vp_+(((i)>>2)*4096+((i)&3)*1024+512)); }while(0)
  #define KRD(G,j) do{ if(G){ kload2(kf,kp0+sl_next,j); SBAR(); } }while(0)
  #define STEP(C0,C1,P0,P1,t,GK,GV,GL) do{ SBAR(); CINIT(C0,C1,t); \
    const lds_cptr vp_=vp0+sl_prev; \
    VRD(0); SBAR(); float sacc=(P0[0]+P0[1]); \
    GAPA(C0=__builtin_amdgcn_mfma_f32_32x32x16_bf16(kf[0],qr[0],C0,0,0,0), P0[2],P0[3],P0[4],P0[5],     pw0[0]=PKW(P0,0), pw0[1]=PKW(P0,2), pw0); \
    VRD(4); SBAR(); GAPA(C1=__builtin_amdgcn_mfma_f32_32x32x16_bf16(kf[1],qr[0],C1,0,0,0), P0[6],P0[7],P0[8],P0[9],     pw0[2]=PKW(P0,4), pw0[3]=PKW(P0,6), pw0); \
    VRD(1); SBAR(); GAPA(C0=__builtin_amdgcn_mfma_f32_32x32x16_bf16(kf[2],qr[1],C0,0,0,0),   P0[10],P0[11],P0[12],P0[13], pw1[0]=PKW(P0,8), pw1[1]=PKW(P0,10), pw1); \
    VRD(5); SBAR(); GAPA(C1=__builtin_amdgcn_mfma_f32_32x32x16_bf16(kf[3],qr[1],C1,0,0,0),   P0[14],P0[15],P1[0],P1[1],   pw1[2]=PKW(P0,12),pw1[3]=PKW(P0,14), pw1); \
    VRD(2); SBAR(); GAPA(C0=__builtin_amdgcn_mfma_f32_32x32x16_bf16(kf[4],qr[2],C0,0,0,0),   P1[2],P1[3],P1[4],P1[5],     pw2[0]=PKW(P1,0), pw2[1]=PKW(P1,2), pw2); \
    VRD(6); SBAR(); GAPA(C1=__builtin_amdgcn_mfma_f32_32x32x16_bf16(kf[5],qr[2],C1,0,0,0),   P1[6],P1[7],P1[8],P1[9],     pw2[2]=PKW(P1,4), pw2[3]=PKW(P1,6), pw2); \
    VRD(3); SBAR(); GAPA(C0=__builtin_amdgcn_mfma_f32_32x32x16_bf16(kf[6],qr[3],C0,0,0,0),   P1[10],P1[11],P1[12],P1[13], pw3[0]=PKW(P1,8), pw3[1]=PKW(P1,10), pw3); \
    VRD(7); SBAR(); GAPA(C1=__builtin_amdgcn_mfma_f32_32x32x16_bf16(kf[7],qr[3],C1,0,0,0),   P1[14],P1[15],0.f,0.f,       pw3[2]=PKW(P1,12),pw3[3]=PKW(P1,14), pw3); \
    l_reg+=sacc; \
    if(GK){DMA_K((t)+3,sl_cur);} if(GV){DMA_V((t)+1,sl_next);} \
    CMASK(C0,C1,t); \
    { float a=MX3(C0[0],C0[1],C1[0]),b=MX3(C0[2],C0[3],C1[1]); a=MX3(a,C1[2],C1[3]); \
      _Pragma("unroll") for(int r=4;r<16;r+=4){a=MX3(a,C0[r],C0[r+1]);b=MX3(b,C0[r+2],C0[r+3]);a=MX3(a,C1[r],C1[r+1]);b=MX3(b,C1[r+2],C1[r+3]);} \
      float rm=__builtin_fmaxf(a,b); { auto rr=__builtin_amdgcn_permlane32_swap(__float_as_uint(rm),__float_as_uint(rm),false,false); rm=__builtin_fmaxf(__uint_as_float(rr[0]),__uint_as_float(rr[1])); } \
      resc=false; \
      if(__builtin_expect(__any(rm>(float)THRL),0)){ const float dl=__builtin_fmaxf(rm,0.f); mhat+=dl; \
        _Pragma("unroll") for(int r=0;r<16;++r){C0[r]-=dl;C1[r]-=dl;} \
        const float f=__builtin_amdgcn_exp2f(-dl); l_reg*=f; if(hi==0)wsf[r32]=f; resc=true; } } \
    SBAR(); \
    GAPB(o[0]=__builtin_amdgcn_mfma_f32_32x32x16_bf16(PAF(0),VFR(0),o[0],0,0,0), C0,0); \
    GAPB(o[1]=__builtin_amdgcn_mfma_f32_32x32x16_bf16(PAF(0),VFR(4),o[1],0,0,0), C0,4); \
    KRD(GL,0); GAPB(o[0]=__builtin_amdgcn_mfma_f32_32x32x16_bf16(PAF(1),VFR(1),o[0],0,0,0), C0,8); \
    KRD(GL,1); GAPB(o[1]=__builtin_amdgcn_mfma_f32_32x32x16_bf16(PAF(1),VFR(5),o[1],0,0,0), C0,12); \
    KRD(GL,2); GAPB(o[0]=__builtin_amdgcn_mfma_f32_32x32x16_bf16(PAF(2),VFR(2),o[0],0,0,0), C1,0); \
    KRD(GL,3); GAPB(o[1]=__builtin_amdgcn_mfma_f32_32x32x16_bf16(PAF(2),VFR(6),o[1],0,0,0), C1,4); \
    GAPB(o[0]=__builtin_amdgcn_mfma_f32_32x32x16_bf16(PAF(3),VFR(3),o[0],0,0,0), C1,8); \
    GAPB(o[1]=__builtin_amdgcn_mfma_f32_32x32x16_bf16(PAF(3),VFR(7),o[1],0,0,0), C1,12); \
    }while(0)
  int t=1;
  #undef CMASK
  #define CMASK(P0,P1,t) do{}while(0)
  for(;t+5<NT;t+=2){
    STEP(pB0,pB1,pA0,pA1,t,true,true,true);     WAIT_BAR(2); RESC(); ROT();
    STEP(pA0,pA1,pB0,pB1,t+1,true,true,true);   WAIT_BAR(2); RESC(); ROT();
  }
  #undef CMASK
  #define CMASK(P0,P1,t) do{int jb_=(t)-(NT-4); if(jb_>=0)cmask(P0,P1,jb_,qrel,hi);}while(0)
  #define ENDW(tt) do{ if((tt)+3<NT){WAIT_BAR(2);} else if((tt)+2<NT){WAIT_BAR(1);} else {WAIT_BAR(0);} }while(0)
  for(;t+1<NT;t+=2){
    STEP(pB0,pB1,pA0,pA1,t,(t+3<NT),(t+1<NT),(t+1<NT));       ENDW(t);   RESC(); ROT();
    STEP(pA0,pA1,pB0,pB1,t+1,(t+4<NT),(t+2<NT),(t+2<NT));     ENDW(t+1); RESC(); ROT();
  }
  STEP(pB0,pB1,pA0,pA1,NT-1,false,false,false); RESC();
  { float sacc=pB0[0]+pB0[1]; _Pragma("unroll") for(int r=2;r<16;++r)sacc+=pB0[r]; _Pragma("unroll") for(int r=0;r<16;++r)sacc+=pB1[r]; l_reg+=sacc;
    pw0=(u32x4){PKW(pB0,0),PKW(pB0,2),PKW(pB0,4),PKW(pB0,6)};pw1=(u32x4){PKW(pB0,8),PKW(pB0,10),PKW(pB0,12),PKW(pB0,14)};pw2=(u32x4){PKW(pB1,0),PKW(pB1,2),PKW(pB1,4),PKW(pB1,6)};pw3=(u32x4){PKW(pB1,8),PKW(pB1,10),PKW(pB1,12),PKW(pB1,14)};
    SBAR(); pv(o,vb0+sl_cur,PAF(0),PAF(1),PAF(2),PAF(3)); }
  #undef PKW
  #undef PAF
  #undef VFR
  #undef PIN
  #undef MX3
  #undef GAPA
  #undef GAPB
  #undef EX
  #undef VRD
  #undef KRD
  #undef STEP
  #undef ENDW
  {auto rr=__builtin_amdgcn_permlane32_swap(__float_as_uint(l_reg),__float_as_uint(l_reg),false,false);l_reg=__uint_as_float(rr[0])+__uint_as_float(rr[1]);}
  if(hi==0)wsf[32+r32]=l_reg;asm volatile("s_waitcnt lgkmcnt(0)":::"memory");
  float rli[16];
  #pragma unroll
  for(int r=0;r<16;++r)rli[r]=__builtin_amdgcn_rcpf(wsf[32+crow(r,hi)]);
  bf16*Ow=O+(rowbase+q0+wid*QBLK)*DMO+OCOL+h*D; const bf16*Gw=G+(rowbase+q0+wid*QBLK)*DM+h*D;
  { bf16*stg=(bf16*)(shm+LDS_OST)+wid*2048;
    #pragma unroll
    for(int r=0;r<16;++r){const int orow=crow(r,hi);
      #pragma unroll
      for(int d0=0;d0<2;++d0)stg[orow*64+d0*32+r32]=__float2bfloat16(o[d0][r]*rli[r]);}
    asm volatile("s_waitcnt lgkmcnt(0)":::"memory");
    #pragma unroll
    for(int i=0;i<4;++i){const int row=i*8+(lane>>3),ch=lane&7; u32x4 v=*(const u32x4*)(stg+row*64+ch*8); const u32x4 g=*(const u32x4*)(Gw+(long)row*DM+ch*8);
      #pragma unroll
      for(int e=0;e<4;++e){ const float o0=__uint_as_float(v[e]<<16),o1=__uint_as_float(v[e]&0xffff0000u),g0=__uint_as_float(g[e]<<16),g1=__uint_as_float(g[e]&0xffff0000u);
        v[e]=cvtpk_s(o0*g0/(1.f+__expf(-g0)),o1*g1/(1.f+__expf(-g1))); }
      ATTN_STORE16(Ow+(long)row*DMO+ch*8,v);} }
  asm volatile("s_waitcnt lgkmcnt(0)\n\ts_barrier":::"memory");
  #undef DMA_K
  #undef DMA_V
  #undef CMASK
  #undef CINIT
  #undef START
  #undef RESC
  #undef ROT
}
constexpr int ATTN_LDS_BYTES=LDS_BYTES;
struct AttnTensors { const bf16* Q; const bf16* K; const bf16* V; const bf16* G; bf16* O; const unsigned* SEL; };
template<int THRL=8> __device__ __forceinline__ void attn_phase(char*lds,const AttnTensors&T,int vcu,int G){
  for(int u=vcu;u<256;u+=G){ const int bh=u>>4,s=u&15;
    attn_unit<THRL>(bh/NHEAD,bh%NHEAD,s,T.Q,T.K,T.V,T.G,T.O,T.SEL,lds);
    attn_unit<THRL>(bh/NHEAD,bh%NHEAD,31-s,T.Q,T.K,T.V,T.G,T.O,T.SEL,lds); }
}
#undef SBAR
#undef WAIT_BAR
}

#define GAS __attribute__((address_space(1)))
#define LAS __attribute__((address_space(3)))
typedef unsigned v4u __attribute__((ext_vector_type(4)));
typedef float f32x4 __attribute__((ext_vector_type(4)));
typedef GAS unsigned gu32;
#define RLX_AGENT __ATOMIC_RELAXED, __HIP_MEMORY_SCOPE_AGENT
#define LDS_WAIT() asm volatile("s_waitcnt lgkmcnt(0)" ::: "memory")
#define VM_WAIT() asm volatile("s_waitcnt vmcnt(0)" ::: "memory")
#define XB_TMO      128
#define XB_XCNT(j)  (256  + 64 * (j))
#define XB_XSUB(j)  (1280 + 64 * (j))
#define XB_XGEN(j)  (2304 + 64 * (j))
#define XB_TOP      3328
#define XB_TOPGEN   3392
#define XCD_BAR_WORDS 3456
#define XB_SPIN_CAP (1u << 18)

__device__ __forceinline__ unsigned xb_ld(unsigned* p)              { return __hip_atomic_load(p, __ATOMIC_RELAXED, __HIP_MEMORY_SCOPE_AGENT); }
__device__ __forceinline__ unsigned xb_add(unsigned* p, unsigned v) { return __hip_atomic_fetch_add(p, v, __ATOMIC_RELAXED, __HIP_MEMORY_SCOPE_AGENT); }
__device__ __forceinline__ unsigned xb_xcc_id() { return (unsigned)__builtin_amdgcn_s_getreg((3 << 11) | 20) & 0xFu; }
#define XB_SPIN(cond, bar) do { unsigned _sp = 0; while (cond) { __builtin_amdgcn_s_sleep(1); \
    if ((++_sp & 255u) == 0u) { if (xb_ld(&(bar)[XB_TMO])) break; if (_sp > XB_SPIN_CAP) { atomicAdd(&(bar)[XB_TMO], 1u); break; } } } } while (0)

struct XcdBarrier {
    unsigned* bar; unsigned x;
    volatile LAS unsigned* st;
};

__device__ __forceinline__ XcdBarrier xcd_barrier_post(unsigned* bar, volatile LAS unsigned* st) {
    XcdBarrier b; b.bar = bar; b.x = xb_xcc_id(); b.st = st;
    if (threadIdx.x == 0) (void)xb_add(&bar[XB_XCNT(b.x)], 1u);
    return b;
}
__device__ __forceinline__ void xcd_barrier_complete(unsigned* bar, unsigned x, unsigned& nloc, unsigned& nx) {
    const unsigned G = gridDim.x * gridDim.y * gridDim.z;
    unsigned sum, cnt, mine, sp = 0u;
    for (;;) {
        sum = 0u; cnt = 0u; mine = 0u;
#pragma unroll
        for (unsigned j = 0; j < 16; ++j) { const unsigned c = xb_ld(&bar[XB_XCNT(j)]); sum += c; cnt += (c > 0u) ? 1u : 0u; mine = (j == x) ? c : mine; }
        if (sum == G) break;
        __builtin_amdgcn_s_sleep(1);
        if ((++sp & 255u) == 0u) { if (xb_ld(&bar[XB_TMO])) break; if (sp > XB_SPIN_CAP) { atomicAdd(&bar[XB_TMO], 1u); break; } }
    }
    nloc = mine > 0u ? mine : 1u; nx = cnt > 0u ? cnt : 1u;
}

__device__ __forceinline__ void xcd_barrier(const XcdBarrier& b) {
    asm volatile("s_waitcnt vmcnt(0)" ::: "memory");
    __syncthreads();
    if (threadIdx.x == 0) {
        unsigned* bar = b.bar;
        __builtin_amdgcn_s_waitcnt(0);
        unsigned nloc = b.st[0], nx = b.st[1];
        if (nloc == 0u) { xcd_barrier_complete(bar, b.x, nloc, nx); b.st[0] = nloc; b.st[1] = nx; }
        const unsigned old = xb_add(&bar[XB_XSUB(b.x)], 1u);
        const unsigned gen = old / nloc;
        if (old + 1u == (gen + 1u) * nloc) {
            __builtin_amdgcn_fence(__ATOMIC_RELEASE, "agent");
            asm volatile("s_waitcnt vmcnt(0)" ::: "memory");
            const unsigned og = xb_add(&bar[XB_TOP], 1u);
            const unsigned tg = og / nx;
            if (og + 1u == (tg + 1u) * nx) xb_add(&bar[XB_TOPGEN], 1u);
            else XB_SPIN(xb_ld(&bar[XB_TOPGEN]) == tg, bar);
            __builtin_amdgcn_fence(__ATOMIC_ACQUIRE, "agent");
            xb_add(&bar[XB_XGEN(b.x)], 1u);
            asm volatile("s_waitcnt vmcnt(0)" ::: "memory");
        } else {
            XB_SPIN(xb_ld(&bar[XB_XGEN(b.x)]) == gen, bar);
            __builtin_amdgcn_fence(__ATOMIC_ACQUIRE, "agent");
            asm volatile("s_waitcnt vmcnt(0)" ::: "memory");
        }
    }
    __syncthreads();
}


constexpr int NWAVES = 8;
constexpr int RING_OFF = 0, RING_BYTES = 131072;
constexpr int LDSCTL_OFF = RING_BYTES, MISC_OFF = LDSCTL_OFF + 320;
constexpr int LDS_BYTES = 147456;
constexpr size_t MiB = 1u << 20;
constexpr size_t WS_CTL = 0, CTL_ZERO_BYTES = 1 * MiB;
constexpr size_t WS_WIN = 1 * MiB;
constexpr size_t WS_WOUT = 16 * MiB;
constexpr size_t WS_DT = 20 * MiB;
constexpr size_t WS_SEL = 22 * MiB;
constexpr size_t WS_KMEAN = 21 * MiB;
constexpr size_t WS_PROJ = 24 * MiB;
constexpr size_t WS_HB = 264 * MiB;
constexpr size_t WS_ST = 328 * MiB;
constexpr size_t WS_END = 480 * MiB;
constexpr int CW_BAR = 4096;

struct Args { const float* in[15]; float* out; unsigned char* ws; int ph_lo, ph_hi, li, pad; };

struct Frame {
    LAS unsigned char* lds;
    volatile LAS unsigned* MISC;
    int tid, lane, wave, vcu, G;
};

__device__ __forceinline__ void p0_transpose_item(const float* W, int ld, int c0, int k0, bf16_t* WT, int row0, LAS float* scr, int lane) {
#pragma unroll 8
    for (int i = 0; i < 32; ++i) { const int kk = 2 * i + (lane >> 5); scr[kk * 33 + (lane & 31)] = W[(size_t)(k0 + kk) * ld + c0 + (lane & 31)]; }
    LDS_WAIT(); asm volatile("" ::: "memory");
    const int c = lane & 7;
#pragma unroll
    for (int j = 0; j < 4; ++j) { const int n = (lane >> 3) + 8 * j; const LAS float* s = scr + (8 * c) * 33 + n;
        v4u o; o.x = pk2(s[0 * 33], s[1 * 33]); o.y = pk2(s[2 * 33], s[3 * 33]); o.z = pk2(s[4 * 33], s[5 * 33]); o.w = pk2(s[6 * 33], s[7 * 33]);
        *(GAS v4u*)(WT + (size_t)(row0 + n) * 1024 + k0 + 8 * c) = o; }
    LDS_WAIT(); asm volatile("" ::: "memory");
}

typedef short bf16x8 __attribute__((ext_vector_type(8)));
typedef float f32x16 __attribute__((ext_vector_type(16)));
#define MFMA32(a, b, c) __builtin_amdgcn_mfma_f32_32x32x16_bf16(a, b, c, 0, 0, 0)
constexpr int TS = 144, TILE = 64 * TS;
constexpr int MX_AUX = 12 * TILE;
constexpr int STG_LD = 260;
constexpr int NCH = L / 64;
constexpr float LOG2E = 1.4426950408889634f;
__device__ __forceinline__ int crow(int r, int hi) { return (r & 3) + 8 * (r >> 2) + 4 * hi; }
__device__ __forceinline__ bf16x8 ldfrag(LAS const unsigned char* tile, int row, int kb) { return *(LAS const bf16x8*)(tile + row * TS + kb); }
__device__ __forceinline__ float fexp2(float x) { return __builtin_amdgcn_exp2f(x); }

constexpr size_t ST_ELEMS = (size_t)NB * NCH * 4 * 4096;
constexpr size_t WS_ST_U = WS_ST;
constexpr size_t WS_ST_DEC = WS_ST + 3 * ST_ELEMS * 2;
constexpr size_t WS_ST_EREF = WS_ST_DEC + (size_t)3 * NB * NCH * 4 * 64 * 4;
constexpr size_t WS_ST_END = WS_ST_EREF + (size_t)3 * NB * NCH * 4 * 64 * 4;

struct MixP {
    const bf16_t* proj; const float* dtraw; bf16_t* ycat;
    bf16_t* U; float* dec; float* eref;
    const float *conv_w, *conv_b, *dt_bias, *a_log, *ssd_d, *ssd_nw, *lb_logits, *hgrn_nw;
    int layer;
};

__device__ __forceinline__ void ld16x2(const bf16_t* p, float (&a)[16], float (&b)[16]) {
    unsigned r[16];
#pragma unroll
    for (int i = 0; i < 16; ++i) r[i] = *(const unsigned*)(p + (size_t)i * PLD);
#pragma unroll
    for (int i = 0; i < 16; ++i) { a[i] = __uint_as_float(r[i] << 16); b[i] = __uint_as_float(r[i] & 0xffff0000u); }
}
__device__ __forceinline__ void st_row16(LAS unsigned char* p, const float (&a)[16]) {
    v4u o0, o1;
    o0.x = pk2(a[0], a[1]); o0.y = pk2(a[2], a[3]); o0.z = pk2(a[4], a[5]); o0.w = pk2(a[6], a[7]);
    o1.x = pk2(a[8], a[9]); o1.y = pk2(a[10], a[11]); o1.z = pk2(a[12], a[13]); o1.w = pk2(a[14], a[15]);
    *(LAS v4u*)p = o0; *(LAS v4u*)(p + 16) = o1;
}

__device__ __forceinline__ void state_core(LAS const unsigned char* VT, LAS const unsigned char* KdT, bf16_t* Uout, int rh, int lane) {
    const int r32 = lane & 31, hi = lane >> 5;
    f32x16 u[2] = {};
#pragma unroll
    for (int ks = 0; ks < 4; ++ks) {
        const bf16x8 a = ldfrag(VT, 32 * rh + r32, 32 * ks + 16 * hi);
#pragma unroll
        for (int ct = 0; ct < 2; ++ct) { const bf16x8 b = ldfrag(KdT, 32 * ct + r32, 32 * ks + 16 * hi); u[ct] = MFMA32(a, b, u[ct]); }
    }
#pragma unroll
    for (int ct = 0; ct < 2; ++ct)
#pragma unroll
        for (int r = 0; r < 16; ++r) Uout[(32 * rh + crow(r, hi)) * 64 + 32 * ct + r32] = f2bf(u[ct][r]);
}

template <bool SCALE>
__device__ __forceinline__ void out_core(LAS unsigned char* lds, int hh, int rh, int lane, const bf16x8 (&sf)[2][4], float diag) {
    const int r32 = lane & 31, hi = lane >> 5;
    LAS unsigned char* Qp = lds + hh * 3 * TILE; LAS unsigned char* Kp = Qp + TILE; LAS unsigned char* VT = Qp + 2 * TILE;
    LAS const float* ra = (LAS const float*)(lds + MX_AUX) + hh * 64; LAS const float* cm = ra + 256;
    bf16x8 af[4];
#pragma unroll
    for (int ks = 0; ks < 4; ++ks) af[ks] = ldfrag(Qp, 32 * rh + r32, 32 * ks + 16 * hi);
    f32x16 p[2] = {}, o2[2] = {};
#pragma unroll
    for (int ks = 0; ks < 4; ++ks) {
        p[0] = MFMA32(af[ks], ldfrag(Kp, r32, 32 * ks + 16 * hi), p[0]);
        if (rh) p[1] = MFMA32(af[ks], ldfrag(Kp, 32 + r32, 32 * ks + 16 * hi), p[1]);
        o2[0] = MFMA32(af[ks], sf[0][ks], o2[0]);
        o2[1] = MFMA32(af[ks], sf[1][ks], o2[1]);
    }
    float rav[16];
#pragma unroll
    for (int r = 0; r < 16; ++r) rav[r] = SCALE ? ra[32 * rh + crow(r, hi)] : 0.f;
#pragma unroll
    for (int ct = 0; ct < 2; ++ct) if (ct == 0 || rh) {
        const int s = 32 * ct + r32;
        const float cas = SCALE ? ra[s] : 0.f, cms = SCALE ? cm[s] : 1.f;
#pragma unroll
        for (int r = 0; r < 16; ++r) {
            const int t = 32 * rh + crow(r, hi);
            float v = p[ct][r];
            if (SCALE) v *= fexp2(fminf(rav[r] - cas, 0.f)) * cms;
            if (s == t) v += diag;
            p[ct][r] = (s <= t) ? v : 0.f;
        }
    }
    __syncthreads();
#pragma unroll
    for (int ct = 0; ct < 2; ++ct) if (ct == 0 || rh) {
#pragma unroll
        for (int r = 0; r < 16; ++r) *(LAS bf16_t*)(Kp + (32 * rh + crow(r, hi)) * TS + (32 * ct + r32) * 2) = f2bf(p[ct][r]);
    }
    __syncthreads();
    f32x16 o[2] = {};
#pragma unroll
    for (int ks = 0; ks < 4; ++ks) if (ks < 2 || rh) {
        const bf16x8 a = ldfrag(Kp, 32 * rh + r32, 32 * ks + 16 * hi);
        o[0] = MFMA32(a, ldfrag(VT, r32, 32 * ks + 16 * hi), o[0]);
        o[1] = MFMA32(a, ldfrag(VT, 32 + r32, 32 * ks + 16 * hi), o[1]);
    }
#pragma unroll
    for (int ct = 0; ct < 2; ++ct)
#pragma unroll
        for (int r = 0; r < 16; ++r) o[ct][r] += (SCALE ? fexp2(rav[r]) : 1.f) * o2[ct][r];
    __syncthreads();
    LAS float* stg = (LAS float*)lds;
#pragma unroll
    for (int ct = 0; ct < 2; ++ct)
#pragma unroll
        for (int r = 0; r < 16; ++r) stg[(32 * rh + crow(r, hi)) * STG_LD + hh * 64 + 32 * ct + r32] = o[ct][r];
    __syncthreads();
}

__device__ __forceinline__ float hgrn_lb(const float* lb_logits, int layer, int ch) {
    if (layer == 0) return 0.f;
    const float l0 = lb_logits[ch], l1 = lb_logits[256 + ch]; const float mx = fmaxf(l0, l1); const float e0 = __expf(l0 - mx), e1 = __expf(l1 - mx); return e1 / (e0 + e1);
}
__device__ __forceinline__ void hgrn_gates(const MixP& P, int tok0, int c0, int q4, int cp, float (&kA)[16], float (&kB)[16], float (&bA)[16], float (&bB)[16],
                                           float& brefA, float& brefB, float& blastA, float& blastB) {
    const float lbA = hgrn_lb(P.lb_logits, P.layer, c0), lbB = hgrn_lb(P.lb_logits, P.layer, c0 + 1);
    ld16x2(P.proj + (size_t)(tok0 + 16 * q4) * PLD + C_HF + c0, kA, kB);
    float ca = 0.f, cb = 0.f;
#pragma unroll
    for (int i = 0; i < 16; ++i) {
        const float fa = lbA + (1.f - lbA) * sigmoid_f(kA[i]), fb = lbB + (1.f - lbB) * sigmoid_f(kB[i]);
        kA[i] = 1.f - fa; kB[i] = 1.f - fb; ca += __logf(fa); cb += __logf(fb); bA[i] = ca; bB[i] = cb;
    }
    const float a0 = __shfl(ca, cp), a1 = __shfl(ca, 16 + cp), a2 = __shfl(ca, 32 + cp), a3 = __shfl(ca, 48 + cp);
    const float b0 = __shfl(cb, cp), b1 = __shfl(cb, 16 + cp), b2 = __shfl(cb, 32 + cp), b3 = __shfl(cb, 48 + cp);
    const float offA = (q4 > 0 ? a0 : 0.f) + (q4 > 1 ? a1 : 0.f) + (q4 > 2 ? a2 : 0.f), offB = (q4 > 0 ? b0 : 0.f) + (q4 > 1 ? b1 : 0.f) + (q4 > 2 ? b2 : 0.f);
#pragma unroll
    for (int i = 0; i < 16; ++i) { bA[i] += offA; bB[i] += offB; }
    brefA = a0 + a1; brefB = b0 + b1; blastA = brefA + a2 + a3; blastB = brefB + b2 + b3;
}

__device__ __forceinline__ void hgrn_state_unit(const Frame& F, const MixP& P, int b, int c) {
    const int w = F.wave, lane = F.lane, q4 = lane >> 4, cp = lane & 15, c0 = 32 * w + 2 * cp, hh = w >> 1, rh = w & 1, d0 = c0 & 63;
    const int tok0 = b * L + 64 * c;
    LAS unsigned char* KdT = F.lds + hh * 3 * TILE; LAS unsigned char* VT = KdT + 2 * TILE;
    float kA[16], kB[16], bA[16], bB[16], brefA, brefB, blA, blB;
    hgrn_gates(P, tok0, c0, q4, cp, kA, kB, bA, bB, brefA, brefB, blA, blB);
#pragma unroll
    for (int i = 0; i < 16; ++i) { kA[i] *= __expf(blA - bA[i]); kB[i] *= __expf(blB - bB[i]); }
    st_row16(KdT + d0 * TS + 32 * q4, kA); st_row16(KdT + (d0 + 1) * TS + 32 * q4, kB);
    ld16x2(P.proj + (size_t)(tok0 + 16 * q4) * PLD + C_HI + c0, kA, kB);
    st_row16(VT + d0 * TS + 32 * q4, kA); st_row16(VT + (d0 + 1) * TS + 32 * q4, kB);
    const size_t uidx = ((size_t)(b * NCH + c) * 4 + hh);
    if (q4 == 0) { *(float2*)(P.dec + uidx * 64 + d0) = make_float2(__expf(blA), __expf(blB)); *(float2*)(P.eref + uidx * 64 + d0) = make_float2(__expf(brefA), __expf(brefB)); }
    __syncthreads();
    state_core(VT, KdT, P.U + uidx * 4096, rh, lane);
    __syncthreads();
}

__device__ __forceinline__ void hgrn_out_unit(const Frame& F, const MixP& P, int b, int c) {
    const int w = F.wave, lane = F.lane, q4 = lane >> 4, cp = lane & 15, c0 = 32 * w + 2 * cp, hh = w >> 1, rh = w & 1, d0 = c0 & 63, r32 = lane & 31, hi = lane >> 5;
    const int tok0 = b * L + 64 * c;
    LAS unsigned char* Qp = F.lds + hh * 3 * TILE; LAS unsigned char* Kp = Qp + TILE; LAS unsigned char* VT = Qp + 2 * TILE;
    const size_t uidx = ((size_t)(b * NCH + c) * 4 + hh);
    bf16x8 sf[2][4];
    { const bf16_t* S = P.U + uidx * 4096;
#pragma unroll
      for (int ct = 0; ct < 2; ++ct)
#pragma unroll
          for (int ks = 0; ks < 4; ++ks) sf[ct][ks] = *(const bf16x8*)(S + (32 * ct + r32) * 64 + 16 * ks + 8 * hi); }
    {
        float kA[16], kB[16], bA[16], bB[16], brefA, brefB, blA, blB;
        hgrn_gates(P, tok0, c0, q4, cp, kA, kB, bA, bB, brefA, brefB, blA, blB);
        float qA[16], qB[16];
        ld16x2(P.proj + (size_t)(tok0 + 16 * q4) * PLD + C_HQ + c0, qA, qB);
#pragma unroll
        for (int i = 0; i < 16; ++i) {
            const int t = 16 * q4 + i;
            const float ea = __expf(fminf(bA[i] - brefA, 80.f)), eb = __expf(fminf(bB[i] - brefB, 80.f));
            const float ka = kA[i] * __expf(fminf(brefA - bA[i], 80.f)), kb = kB[i] * __expf(fminf(brefB - bB[i], 80.f));
            *(LAS unsigned*)(Qp + t * TS + d0 * 2) = pk2(qA[i] * ea, qB[i] * eb);
            *(LAS unsigned*)(Kp + t * TS + d0 * 2) = pk2(ka, kb);
        }
        ld16x2(P.proj + (size_t)(tok0 + 16 * q4) * PLD + C_HI + c0, qA, qB);
        st_row16(VT + d0 * TS + 32 * q4, qA); st_row16(VT + (d0 + 1) * TS + 32 * q4, qB);
    }
    __syncthreads();
    out_core<false>(F.lds, hh, rh, lane, sf, 0.f);
    {
        const int row = F.tid >> 3, seg = F.tid & 7;
        LAS const float* stg = (LAS const float*)F.lds + row * STG_LD;
        const bf16_t* gp = P.proj + (size_t)(tok0 + row) * PLD + C_HG;
        bf16_t* yp = P.ycat + (size_t)(tok0 + row) * D + 256;
        f32x4 v[8]; float ss[4] = {0.f, 0.f, 0.f, 0.f};
#pragma unroll
        for (int j = 0; j < 8; ++j) { v[j] = *(LAS const f32x4*)(stg + 4 * (seg + 8 * j)); ss[j >> 1] += v[j].x * v[j].x + v[j].y * v[j].y + v[j].z * v[j].z + v[j].w * v[j].w; }
#pragma unroll
        for (int k = 0; k < 4; ++k) { ss[k] += __shfl_xor(ss[k], 1); ss[k] += __shfl_xor(ss[k], 2); ss[k] += __shfl_xor(ss[k], 4); ss[k] = rsqrtf(ss[k] * (1.f / 64.f) + RMS_EPS); }
#pragma unroll
        for (int j = 0; j < 8; ++j) {
            const int ch = 4 * (seg + 8 * j);
            const uint2 g2 = *(const uint2*)(gp + ch); const f32x4 nw = *(const f32x4*)(P.hgrn_nw + ch);
            const float g0 = __uint_as_float(g2.x << 16), g1 = __uint_as_float(g2.x & 0xffff0000u), g2f = __uint_as_float(g2.y << 16), g3 = __uint_as_float(g2.y & 0xffff0000u);
            const float r = ss[j >> 1];
            uint2 o; o.x = pk2(v[j].x * r * nw.x * silu_f(g0), v[j].y * r * nw.y * silu_f(g1)); o.y = pk2(v[j].z * r * nw.z * silu_f(g2f), v[j].w * r * nw.w * silu_f(g3));
            *(uint2*)(yp + ch) = o;
        }
    }
    __syncthreads();
}

__device__ __forceinline__ void scan_phase(const Frame& F, bf16_t* Uall, const float* decall, const float* erefall, int mx_lo, int mx_hi) {
    const int nthreads = F.G * NWAVES * 64;
    const int gt = (F.vcu * NWAVES + F.wave) * 64 + F.lane;
    const int per_mx = NB * 4 * 2048;
    for (int it = gt; it < (mx_hi - mx_lo) * per_mx; it += nthreads) {
        const int mx = mx_lo + it / per_mx; int r = it % per_mx;
        const int b = r / (4 * 2048); r %= (4 * 2048); const int h = r / 2048; const int e = r % 2048;
        const int d = (e & 31) * 2;
        bf16_t* U = Uall + (size_t)mx * ST_ELEMS + ((size_t)(b * NCH) * 4 + h) * 4096 + (size_t)e * 2;
        const float* dec = decall + ((size_t)mx * NB * NCH * 4 + (size_t)(b * NCH) * 4 + h) * 64 + d;
        const float* er = erefall + ((size_t)mx * NB * NCH * 4 + (size_t)(b * NCH) * 4 + h) * 64 + d;
        float s0 = 0.f, s1 = 0.f;
#pragma unroll 8
        for (int c = 0; c < NCH; ++c) {
            const unsigned u = *(const unsigned*)(U + (size_t)c * 4 * 4096);
            const float2 dc = *(const float2*)(dec + (size_t)c * 4 * 64);
            float e0 = 1.f, e1 = 1.f;
            if (mx == 1) { const float2 ee = *(const float2*)(er + (size_t)c * 4 * 64); e0 = ee.x; e1 = ee.y; }
            *(unsigned*)(U + (size_t)c * 4 * 4096) = pk2(s0 * e0, s1 * e1);
            s0 = dc.x * s0 + __uint_as_float(u << 16); s1 = dc.y * s1 + __uint_as_float(u & 0xffff0000u);
        }
    }
}

__device__ __forceinline__ float ret_lg(int h) { return __log2f(1.f - exp2f(-5.f - (float)h)); }
__device__ __forceinline__ void ret_state_unit(const Frame& F, const MixP& P, int b, int c) {
    const int w = F.wave, lane = F.lane, q4 = lane >> 4, cp = lane & 15, c0 = 32 * w + 2 * cp, hh = w >> 1, rh = w & 1, d0 = c0 & 63;
    const int tok0 = b * L + 64 * c;
    LAS unsigned char* KdT = F.lds + hh * 3 * TILE; LAS unsigned char* VT = KdT + 2 * TILE;
    const float lg = ret_lg(hh);
    float kA[16], kB[16];
    ld16x2(P.proj + (size_t)(tok0 + 16 * q4) * PLD + C_RK + c0, kA, kB);
#pragma unroll
    for (int i = 0; i < 16; ++i) { const float e = 0.125f * fexp2(lg * (float)(63 - 16 * q4 - i)); kA[i] *= e; kB[i] *= e; }
    st_row16(KdT + d0 * TS + 32 * q4, kA); st_row16(KdT + (d0 + 1) * TS + 32 * q4, kB);
    ld16x2(P.proj + (size_t)(tok0 + 16 * q4) * PLD + C_RV + c0, kA, kB);
    st_row16(VT + d0 * TS + 32 * q4, kA); st_row16(VT + (d0 + 1) * TS + 32 * q4, kB);
    const size_t uidx = ((size_t)(b * NCH + c) * 4 + hh);
    if (rh == 0) P.dec[uidx * 64 + lane] = fexp2(lg * 64.f);
    __syncthreads();
    state_core(VT, KdT, P.U + uidx * 4096, rh, lane);
    __syncthreads();
}
__device__ __forceinline__ void ret_out_unit(const Frame& F, const MixP& P, int b, int c) {
    const int w = F.wave, lane = F.lane, q4 = lane >> 4, cp = lane & 15, c0 = 32 * w + 2 * cp, hh = w >> 1, rh = w & 1, d0 = c0 & 63, r32 = lane & 31, hi = lane >> 5;
    const int tok0 = b * L + 64 * c;
    LAS unsigned char* Qp = F.lds + hh * 3 * TILE; LAS unsigned char* Kp = Qp + TILE; LAS unsigned char* VT = Qp + 2 * TILE;
    LAS float* ra = (LAS float*)(F.lds + MX_AUX) + hh * 64; LAS float* cm = ra + 256;
    const size_t uidx = ((size_t)(b * NCH + c) * 4 + hh);
    bf16x8 sf[2][4];
    { const bf16_t* S = P.U + uidx * 4096;
#pragma unroll
      for (int ct = 0; ct < 2; ++ct)
#pragma unroll
          for (int ks = 0; ks < 4; ++ks) sf[ct][ks] = *(const bf16x8*)(S + (32 * ct + r32) * 64 + 16 * ks + 8 * hi); }
    {
        float qA[16], qB[16];
        ld16x2(P.proj + (size_t)(tok0 + 16 * q4) * PLD + C_RQ + c0, qA, qB);
#pragma unroll
        for (int i = 0; i < 16; ++i) *(LAS unsigned*)(Qp + (16 * q4 + i) * TS + d0 * 2) = pk2(qA[i], qB[i]);
        ld16x2(P.proj + (size_t)(tok0 + 16 * q4) * PLD + C_RK + c0, qA, qB);
#pragma unroll
        for (int i = 0; i < 16; ++i) *(LAS unsigned*)(Kp + (16 * q4 + i) * TS + d0 * 2) = pk2(qA[i] * 0.125f, qB[i] * 0.125f);
        ld16x2(P.proj + (size_t)(tok0 + 16 * q4) * PLD + C_RV + c0, qA, qB);
        st_row16(VT + d0 * TS + 32 * q4, qA); st_row16(VT + (d0 + 1) * TS + 32 * q4, qB);
        if (rh == 0) { ra[lane] = ret_lg(hh) * (float)(lane + 1); cm[lane] = 1.f; }
    }
    __syncthreads();
    out_core<true>(F.lds, hh, rh, lane, sf, 0.f);
    {
        const int row = F.tid >> 3, seg = F.tid & 7;
        LAS const float* stg = (LAS const float*)F.lds + row * STG_LD;
        const bf16_t* gp = P.proj + (size_t)(tok0 + row) * PLD + C_RG;
        bf16_t* yp = P.ycat + (size_t)(tok0 + row) * D + 512;
        f32x4 v[8]; float mu[4] = {0.f, 0.f, 0.f, 0.f}, ss[4] = {0.f, 0.f, 0.f, 0.f};
#pragma unroll
        for (int j = 0; j < 8; ++j) { v[j] = *(LAS const f32x4*)(stg + 4 * (seg + 8 * j)); mu[j >> 1] += (v[j].x + v[j].y) + (v[j].z + v[j].w); }
#pragma unroll
        for (int k = 0; k < 4; ++k) { mu[k] += __shfl_xor(mu[k], 1); mu[k] += __shfl_xor(mu[k], 2); mu[k] += __shfl_xor(mu[k], 4); mu[k] *= (1.f / 64.f); }
#pragma unroll
        for (int j = 0; j < 8; ++j) { v[j] = v[j] - mu[j >> 1]; ss[j >> 1] += v[j].x * v[j].x + v[j].y * v[j].y + v[j].z * v[j].z + v[j].w * v[j].w; }
#pragma unroll
        for (int k = 0; k < 4; ++k) { ss[k] += __shfl_xor(ss[k], 1); ss[k] += __shfl_xor(ss[k], 2); ss[k] += __shfl_xor(ss[k], 4); ss[k] = rsqrtf(ss[k] * (1.f / 64.f) + LN_EPS); }
#pragma unroll
        for (int j = 0; j < 8; ++j) {
            const int ch = 4 * (seg + 8 * j);
            const uint2 g2 = *(const uint2*)(gp + ch);
            const float g0 = __uint_as_float(g2.x << 16), g1 = __uint_as_float(g2.x & 0xffff0000u), g2f = __uint_as_float(g2.y << 16), g3 = __uint_as_float(g2.y & 0xffff0000u);
            const float r = ss[j >> 1];
            uint2 o; o.x = pk2(v[j].x * r * silu_f(g0), v[j].y * r * silu_f(g1)); o.y = pk2(v[j].z * r * silu_f(g2f), v[j].w * r * silu_f(g3));
            *(uint2*)(yp + ch) = o;
        }
    }
    __syncthreads();
}

__device__ __forceinline__ void ssd_conv(const MixP& P, int tok0, bool first_chunk, int q4, int xch, float (&aA)[16], float (&aB)[16]) {
    unsigned r[19];
    const bf16_t* p = P.proj + (size_t)(tok0 + 16 * q4) * PLD + C_XBC + xch;
#pragma unroll
    for (int i = 0; i < 19; ++i) r[i] = (first_chunk && q4 == 0 && i < 3) ? 0u : *(const unsigned*)(p + (ptrdiff_t)(i - 3) * PLD);
    float wA[4], wB[4];
#pragma unroll
    for (int j = 0; j < 4; ++j) { wA[j] = P.conv_w[j * 512 + xch]; wB[j] = P.conv_w[j * 512 + xch + 1]; }
    const float cbA = P.conv_b[xch], cbB = P.conv_b[xch + 1];
#pragma unroll
    for (int i = 0; i < 16; ++i) {
        float sa = cbA, sb = cbB;
#pragma unroll
        for (int j = 0; j < 4; ++j) { sa += wA[j] * __uint_as_float(r[i + j] << 16); sb += wB[j] * __uint_as_float(r[i + j] & 0xffff0000u); }
        aA[i] = silu_f(sa); aB[i] = silu_f(sb);
    }
}
__device__ __forceinline__ void ssd_dt(const MixP& P, int tok0, int hh, int lane, float& dt, float& acum, float& alast) {
    const float r = P.dtraw[(size_t)(tok0 + lane) * 4 + hh] + P.dt_bias[hh];
    dt = r > 20.f ? r : log1pf(__expf(r));
    float a = dt * (-__expf(P.a_log[hh]));
#pragma unroll
    for (int o = 1; o < 64; o <<= 1) { const float n = __shfl_up(a, o); if (lane >= o) a += n; }
    acum = a; alast = __shfl(a, 63);
}
__device__ __forceinline__ void ssd_state_unit(const Frame& F, const MixP& P, int b, int c) {
    const int w = F.wave, lane = F.lane, q4 = lane >> 4, cp = lane & 15, c0 = 32 * w + 2 * cp, hh = w >> 1, rh = w & 1, d0 = c0 & 63;
    const int tok0 = b * L + 64 * c;
    LAS float* wv = (LAS float*)(F.lds + MX_AUX);
    const size_t uidx = ((size_t)(b * NCH + c) * 4 + hh);
    { float dt, acum, alast; ssd_dt(P, tok0, hh, lane, dt, acum, alast);
      if (rh == 0) { wv[hh * 64 + lane] = dt * __expf(alast - acum); P.dec[uidx * 64 + lane] = __expf(alast); } }
    float aA[16], aB[16];
    ssd_conv(P, tok0, c == 0, q4, c0, aA, aB);
    { LAS unsigned char* VT = F.lds + hh * 3 * TILE + 2 * TILE; st_row16(VT + d0 * TS + 32 * q4, aA); st_row16(VT + (d0 + 1) * TS + 32 * q4, aB); }
    __syncthreads();
    if (w < 4) {
        ssd_conv(P, tok0, c == 0, q4, 256 + c0, aA, aB);
        const int g = w >> 1;
#pragma unroll
        for (int hx = 0; hx < 2; ++hx) {
            const int h2 = 2 * g + hx; LAS unsigned char* KdT = F.lds + h2 * 3 * TILE;
            float tA[16], tB[16];
#pragma unroll
            for (int i = 0; i < 16; ++i) { const float ww = wv[h2 * 64 + 16 * q4 + i]; tA[i] = aA[i] * ww; tB[i] = aB[i] * ww; }
            st_row16(KdT + d0 * TS + 32 * q4, tA); st_row16(KdT + (d0 + 1) * TS + 32 * q4, tB);
        }
    }
    __syncthreads();
    state_core(F.lds + hh * 3 * TILE + 2 * TILE, F.lds + hh * 3 * TILE, P.U + uidx * 4096, rh, lane);
    __syncthreads();
}
__device__ __forceinline__ void ssd_out_unit(const Frame& F, const MixP& P, int b, int c) {
    const int w = F.wave, lane = F.lane, q4 = lane >> 4, cp = lane & 15, c0 = 32 * w + 2 * cp, hh = w >> 1, rh = w & 1, d0 = c0 & 63, r32 = lane & 31, hi = lane >> 5;
    const int tok0 = b * L + 64 * c;
    LAS float* ra = (LAS float*)(F.lds + MX_AUX) + hh * 64; LAS float* cm = ra + 256;
    const size_t uidx = ((size_t)(b * NCH + c) * 4 + hh);
    bf16x8 sf[2][4];
    { const bf16_t* S = P.U + uidx * 4096;
#pragma unroll
      for (int ct = 0; ct < 2; ++ct)
#pragma unroll
          for (int ks = 0; ks < 4; ++ks) sf[ct][ks] = *(const bf16x8*)(S + (32 * ct + r32) * 64 + 16 * ks + 8 * hi); }
    { float dt, acum, alast; ssd_dt(P, tok0, hh, lane, dt, acum, alast); if (rh == 0) { ra[lane] = acum * LOG2E; cm[lane] = dt; } }
    {
        float aA[16], aB[16];
        ssd_conv(P, tok0, c == 0, q4, c0, aA, aB);
        LAS unsigned char* VT = F.lds + hh * 3 * TILE + 2 * TILE; st_row16(VT + d0 * TS + 32 * q4, aA); st_row16(VT + (d0 + 1) * TS + 32 * q4, aB);
        ssd_conv(P, tok0, c == 0, q4, 256 + c0, aA, aB);
        const int g = (w & 3) >> 1; const int slot = (w < 4) ? TILE : 0;
#pragma unroll
        for (int hx = 0; hx < 2; ++hx) { LAS unsigned char* T = F.lds + (2 * g + hx) * 3 * TILE + slot;
#pragma unroll
            for (int i = 0; i < 16; ++i) *(LAS unsigned*)(T + (16 * q4 + i) * TS + d0 * 2) = pk2(aA[i], aB[i]); }
    }
    __syncthreads();
    out_core<true>(F.lds, hh, rh, lane, sf, P.ssd_d[hh]);
    {
        const int row = F.tid >> 3, seg = F.tid & 7;
        LAS const float* stg = (LAS const float*)F.lds + row * STG_LD;
        const bf16_t* zp = P.proj + (size_t)(tok0 + row) * PLD + C_SZ;
        bf16_t* yp = P.ycat + (size_t)(tok0 + row) * D;
        f32x4 v[8]; float ss[2] = {0.f, 0.f};
#pragma unroll
        for (int j = 0; j < 8; ++j) {
            const int ch = 4 * (seg + 8 * j);
            v[j] = *(LAS const f32x4*)(stg + ch);
            const uint2 z2 = *(const uint2*)(zp + ch);
            v[j].x *= silu_f(__uint_as_float(z2.x << 16)); v[j].y *= silu_f(__uint_as_float(z2.x & 0xffff0000u));
            v[j].z *= silu_f(__uint_as_float(z2.y << 16)); v[j].w *= silu_f(__uint_as_float(z2.y & 0xffff0000u));
            ss[j >> 2] += v[j].x * v[j].x + v[j].y * v[j].y + v[j].z * v[j].z + v[j].w * v[j].w;
        }
#pragma unroll
        for (int k = 0; k < 2; ++k) { ss[k] += __shfl_xor(ss[k], 1); ss[k] += __shfl_xor(ss[k], 2); ss[k] += __shfl_xor(ss[k], 4); ss[k] = rsqrtf(ss[k] * (1.f / 128.f) + RMS_EPS); }
#pragma unroll
        for (int j = 0; j < 8; ++j) {
            const int ch = 4 * (seg + 8 * j);
            const f32x4 nw = *(const f32x4*)(P.ssd_nw + ch); const float r = ss[j >> 2];
            uint2 o; o.x = pk2(v[j].x * r * nw.x, v[j].y * r * nw.y); o.y = pk2(v[j].z * r * nw.z, v[j].w * r * nw.w);
            *(uint2*)(yp + ch) = o;
        }
    }
    __syncthreads();
}

__device__ __forceinline__ void moba_kmean_unit(const Frame& F, const bf16_t* proj, float* kmean, int b, int n) {
    const int ch = F.tid & 255, half = F.tid >> 8;
    const bf16_t* p = proj + ((size_t)b * L + n * 256 + half * 128) * PLD + C_MK + ch;
    float s = 0.f;
#pragma unroll 16
    for (int j = 0; j < 128; ++j) s += bf2f(p[(size_t)j * PLD]);
    LAS float* sh = (LAS float*)F.lds;
    if (half) sh[ch] = s;
    __syncthreads();
    if (!half) { s += sh[ch]; kmean[(((size_t)(b * 4 + (ch >> 6))) * 32 + n) * 64 + (ch & 63)] = s * (1.f / 256.f); }
    __syncthreads();
}
__device__ __forceinline__ void moba_topk_unit(const Frame& F, const bf16_t* proj, const float* kmean, unsigned* sel, int b, int j) {
    LAS float* km = (LAS float*)F.lds;
    for (int i = F.tid; i < 4 * 32 * 64 / 4; i += NWAVES * 64) ((LAS f32x4*)km)[i] = ((const f32x4*)(kmean + (size_t)b * 4 * 32 * 64))[i];
    __syncthreads();
    const int h = __builtin_amdgcn_readfirstlane(F.tid >> 7), tl = F.tid & 127;
#pragma unroll 1
    for (int pass = 0; pass < 2; ++pass) {
        const int t = j * 256 + pass * 128 + tl;
        float q[64];
        { const v4u* qp = (const v4u*)(proj + ((size_t)b * L + t) * PLD + C_MQ + h * 64);
#pragma unroll
          for (int i = 0; i < 8; ++i) { const v4u r = qp[i];
              q[8 * i + 0] = __uint_as_float(r.x << 16); q[8 * i + 1] = __uint_as_float(r.x & 0xffff0000u); q[8 * i + 2] = __uint_as_float(r.y << 16); q[8 * i + 3] = __uint_as_float(r.y & 0xffff0000u);
              q[8 * i + 4] = __uint_as_float(r.z << 16); q[8 * i + 5] = __uint_as_float(r.z & 0xffff0000u); q[8 * i + 6] = __uint_as_float(r.w << 16); q[8 * i + 7] = __uint_as_float(r.w & 0xffff0000u); } }
        float sc[32];
#pragma unroll
        for (int n = 0; n < 32; ++n) {
            sc[n] = -INFINITY;
            if (n < j) {
                LAS const f32x4* kr = (LAS const f32x4*)(km + (h * 32 + n) * 64);
                float s0 = 0.f, s1 = 0.f;
#pragma unroll
                for (int d4 = 0; d4 < 16; d4 += 2) { const f32x4 a = kr[d4], c = kr[d4 + 1];
                    s0 += q[4 * d4] * a.x + q[4 * d4 + 1] * a.y + q[4 * d4 + 2] * a.z + q[4 * d4 + 3] * a.w;
                    s1 += q[4 * d4 + 4] * c.x + q[4 * d4 + 5] * c.y + q[4 * d4 + 6] * c.z + q[4 * d4 + 7] * c.w; }
                sc[n] = s0 + s1;
            }
        }
        unsigned m = 0u;
#pragma unroll
        for (int r = 0; r < 3; ++r) {
            float best = -INFINITY; int bi = 0;
#pragma unroll
            for (int n = 0; n < 32; ++n) if (sc[n] > best) { best = sc[n]; bi = n; }
            if (best > -INFINITY) {
                m |= 1u << bi;
#pragma unroll
                for (int n = 0; n < 32; ++n) if (n == bi) sc[n] = -INFINITY;
            }
        }
        sel[((size_t)(b * 4 + h)) * L + t] = m;
    }
    __syncthreads();
}


__device__ __forceinline__ void ln_phase(const Frame& F, const float* src, const float* g, const float* b, float* hout, bf16_t* hb, const float* wdt  , float* dtraw) {
    const int lane = F.lane;
    const int gw = F.vcu * NWAVES + F.wave, NGW = F.G * NWAVES;
    f32x4 gg[4], bb[4];
#pragma unroll
    for (int j = 0; j < 4; ++j) { gg[j] = ((const f32x4*)g)[lane + 64 * j]; bb[j] = ((const f32x4*)b)[lane + 64 * j]; }
    for (int row = gw; row < M; row += NGW) {
        const f32x4* xr = (const f32x4*)(src + (size_t)row * D) + lane;
        f32x4 v[4]; float s = 0.f;
#pragma unroll
        for (int j = 0; j < 4; ++j) { v[j] = xr[64 * j]; s += (v[j].x + v[j].y) + (v[j].z + v[j].w); }
        const float mean = wave_sum(s) * (1.f / D); float s2 = 0.f;
#pragma unroll
        for (int j = 0; j < 4; ++j) { v[j] = v[j] - mean; s2 += (v[j].x * v[j].x + v[j].y * v[j].y) + (v[j].z * v[j].z + v[j].w * v[j].w); }
        const float rstd = rsqrtf(wave_sum(s2) * (1.f / D) + LN_EPS);
#pragma unroll
        for (int j = 0; j < 4; ++j) v[j] = v[j] * rstd * gg[j] + bb[j];
        f32x4* o = (f32x4*)(hout + (size_t)row * D) + lane;
#pragma unroll
        for (int j = 0; j < 4; ++j) o[64 * j] = v[j];
        if (hb) {
            unsigned long long* o8 = (unsigned long long*)(hb + (size_t)row * D) + lane;
#pragma unroll
            for (int j = 0; j < 4; ++j) o8[64 * j] = (unsigned long long)pk2(v[j].x, v[j].y) | ((unsigned long long)pk2(v[j].z, v[j].w) << 32);
            f32x4 da = (f32x4){0.f, 0.f, 0.f, 0.f};
#pragma unroll
            for (int j = 0; j < 4; ++j) {
                const int k = 4 * lane + 256 * j;
                const f32x4 w0 = *(const f32x4*)(wdt + (size_t)(k + 0) * NIN), w1 = *(const f32x4*)(wdt + (size_t)(k + 1) * NIN),
                            w2 = *(const f32x4*)(wdt + (size_t)(k + 2) * NIN), w3 = *(const f32x4*)(wdt + (size_t)(k + 3) * NIN);
                da += w0 * v[j].x + w1 * v[j].y + w2 * v[j].z + w3 * v[j].w;
            }
            da.x = wave_sum(da.x); da.y = wave_sum(da.y); da.z = wave_sum(da.z); da.w = wave_sum(da.w);
            if (lane == 0) *(f32x4*)(dtraw + (size_t)row * 4) = da;
        }
    }
}

template <int l>
__device__ __forceinline__ void layer_body(const Frame& F, const Args& args, const XcdBarrier& bar, int lo, int hi, char* ldsg) {
    unsigned char* ws = args.ws;
    const float* w_in = args.in[3];
    float* hres = args.out;
    bf16_t* WTin = (bf16_t*)(ws + WS_WIN);
    bf16_t* WTout = (bf16_t*)(ws + WS_WOUT);
    float* dtraw = (float*)(ws + WS_DT);
    bf16_t* proj = (bf16_t*)(ws + WS_PROJ);
    float* zbuf = (float*)(ws + WS_PROJ);
    bf16_t* hb = (bf16_t*)(ws + WS_HB);
    bf16_t* ycat = (bf16_t*)(ws + WS_HB);
    float* kmean = (float*)(ws + WS_KMEAN);
    unsigned* selm = (unsigned*)(ws + WS_SEL);
#define IN(k) (lo <= (k) && (k) < hi)
#define SEAM(k) do { if (IN(k) && IN((k) + 1)) xcd_barrier(bar); } while (0)
        const int pb = 1 + 6 * l;
        if (IN(pb)) {
            pg8::Gemm g{hb, WTin + (size_t)l * PLD * D, M, PLD, D}; pg8::StaticOrder S; S.init(M, PLD, F.G, (int)blockIdx.x);
            pg8::EpiProj E{proj, QC2};
            pg8::gemm_phase<pg8::EpiProj, pg8::StaticOrder, true, true>(F.lds + RING_OFF, g, S, E);
        }
        SEAM(pb);
        MixP P;
        P.proj = proj; P.dtraw = dtraw; P.ycat = ycat; P.U = (bf16_t*)(ws + WS_ST_U); P.dec = (float*)(ws + WS_ST_DEC); P.eref = (float*)(ws + WS_ST_EREF);
        P.conv_w = args.in[4] + l * 4 * 512; P.conv_b = args.in[5] + l * 512; P.dt_bias = args.in[6] + l * 4; P.a_log = args.in[7] + l * 4; P.ssd_d = args.in[8] + l * 4;
        P.ssd_nw = args.in[9] + l * 256; P.lb_logits = args.in[10]; P.hgrn_nw = args.in[11] + l * 256; P.layer = l;
        MixP Ph = P; Ph.U = P.U + ST_ELEMS; Ph.dec = P.dec + (size_t)NB * NCH * 4 * 64; Ph.eref = P.eref + (size_t)NB * NCH * 4 * 64;
        MixP Pr = P; Pr.U = P.U + 2 * ST_ELEMS; Pr.dec = P.dec + (size_t)2 * NB * NCH * 4 * 64;
        if (IN(pb + 1)) {
            for (int u = F.vcu; u < 3 * NB * NCH; u += F.G) { const int mx = u / (NB * NCH), r = u % (NB * NCH);
                if (mx == 0) ssd_state_unit(F, P, r / NCH, r % NCH); else if (mx == 1) hgrn_state_unit(F, Ph, r / NCH, r % NCH); else ret_state_unit(F, Pr, r / NCH, r % NCH); }
            for (int u = F.vcu; u < NB * 32; u += F.G) moba_kmean_unit(F, proj, kmean, u >> 5, u & 31);
        }
        SEAM(pb + 1);
        if (IN(pb + 2)) { scan_phase(F, P.U, P.dec, P.eref, 0, 3);
            for (int u = F.vcu; u < NB * 32; u += F.G) moba_topk_unit(F, proj, kmean, selm, u >> 5, u & 31); }
        SEAM(pb + 2);
        if (IN(pb + 3)) {
            for (int u = F.vcu; u < 3 * NB * NCH; u += F.G) { const int mx = u / (NB * NCH), r = u % (NB * NCH);
                if (mx == 0) ssd_out_unit(F, P, r / NCH, r % NCH); else if (mx == 1) hgrn_out_unit(F, Ph, r / NCH, r % NCH); else ret_out_unit(F, Pr, r / NCH, r % NCH); }
            { const attn_body::AttnTensors AT{(const attn_body::bf16*)(proj + C_MQ), (const attn_body::bf16*)(proj + C_MK), (const attn_body::bf16*)(proj + C_MV), (const attn_body::bf16*)(proj + C_MG), (attn_body::bf16*)ycat, selm};
              attn_body::attn_phase<8>(ldsg + RING_OFF, AT, F.vcu, F.G); }
        }
        SEAM(pb + 3);
        if (IN(pb + 4)) {
            pg8::Gemm g{ycat, WTout + (size_t)l * D * D, M, D, D}; pg8::StaticOrder S; S.init(M, D, F.G, (int)blockIdx.x);
            pg8::EpiZ E{zbuf, hres, ALPHA};
            pg8::gemm_phase<pg8::EpiZ, pg8::StaticOrder, true, true>(F.lds + RING_OFF, g, S, E);
        }
        SEAM(pb + 4);
        if (IN(pb + 5)) {
            if (l == 0) ln_phase(F, zbuf, args.in[13], args.in[14], hres, hb, w_in + (size_t)D * NIN + 768, dtraw);
            else ln_phase(F, zbuf, args.in[13] + D, args.in[14] + D, hres, nullptr, nullptr, nullptr);
        }
        SEAM(pb + 5);

#undef IN
#undef SEAM
}

__global__ void __launch_bounds__(NWAVES * 64, 2) mk_fwd(Args args) {
    extern __shared__ __attribute__((aligned(16))) unsigned char lds[];
    Frame F;
    F.lds = (LAS unsigned char*)lds;
    F.MISC = (volatile LAS unsigned*)(F.lds + MISC_OFF);
    F.tid = threadIdx.x; F.lane = F.tid & 63; F.wave = __builtin_amdgcn_readfirstlane(F.tid >> 6);
    F.G = gridDim.x; { const int bx = blockIdx.x; F.vcu = (F.G % 8 == 0) ? (bx % 8) * (F.G / 8) + bx / 8 : bx; }
    unsigned char* ws = args.ws;
    for (int u = F.tid; u < (LDS_BYTES - LDSCTL_OFF) / 4; u += NWAVES * 64) ((LAS unsigned*)(F.lds + LDSCTL_OFF))[u] = 0u;
    __syncthreads();
    XcdBarrier bar = xcd_barrier_post((unsigned*)(ws + WS_CTL) + CW_BAR + args.li * XCD_BAR_WORDS, F.MISC + 8);
    const int lo = args.ph_lo, hi = args.ph_hi;
#define IN(k) (lo <= (k) && (k) < hi)
#define SEAM(k) do { if (IN(k) && IN((k) + 1)) xcd_barrier(bar); } while (0)

    const float* x = args.in[0];
    const float* w_in = args.in[3];
    const float* w_out = args.in[12];
    float* hres = args.out;
    bf16_t* WTin = (bf16_t*)(ws + WS_WIN);
    bf16_t* WTout = (bf16_t*)(ws + WS_WOUT);
    float* dtraw = (float*)(ws + WS_DT);
    bf16_t* proj = (bf16_t*)(ws + WS_PROJ);
    float* zbuf = (float*)(ws + WS_PROJ);
    bf16_t* hb = (bf16_t*)(ws + WS_HB);
    bf16_t* ycat = (bf16_t*)(ws + WS_HB);

    if (IN(0)) {
        LAS float* scr = (LAS float*)(F.lds + RING_OFF + F.wave * 16384);
        const int gw = F.vcu * NWAVES + F.wave, NGW = F.G * NWAVES;
        constexpr int I_IN = 120 * 16, I_OUT = 32 * 16, I_L = I_IN + I_OUT;
        for (int it = gw; it < 2 * I_L; it += NGW) {
            const int l = it / I_L; int r = it % I_L;
            if (r < I_IN) { const int nb = r % 120, kb = r / 120; const int n0 = 32 * nb; const int c0 = n0 < 768 ? n0 : n0 + 4;
                p0_transpose_item(w_in + (size_t)l * D * NIN, NIN, c0, 64 * kb, WTin + (size_t)l * PLD * D, n0, scr, F.lane); }
            else { r -= I_IN; const int nb = r % 32, kb = r / 32;
                p0_transpose_item(w_out + (size_t)l * D * D, D, 32 * nb, 64 * kb, WTout + (size_t)l * D * D, 32 * nb, scr, F.lane); }
        }
        ln_phase(F, x, args.in[1], args.in[2], hres, hb, w_in + 768, dtraw);
    }
    SEAM(0);
    layer_body<0>(F, args, bar, lo, hi, (char*)lds);
    layer_body<1>(F, args, bar, lo, hi, (char*)lds);
#undef IN
#undef SEAM
}

static void launch_mk(const Args& a0, int lo, int hi, int li, int grid, hipStream_t stream) {
    Args a = a0; a.ph_lo = lo; a.ph_hi = hi; a.li = li;
    hipLaunchKernelGGL(mk_fwd, dim3(grid), dim3(NWAVES * 64), LDS_BYTES, stream, a);
}

extern "C" void kernel_launch(void* const* d_in, const int* in_sizes, int n_in, void* d_out, int out_size, void* d_ws, size_t ws_size, hipStream_t stream) {
    static int grid = 0;
    if (grid == 0) {
        int dev = 0, cus = 0;
        if (hipGetDevice(&dev) != hipSuccess || hipDeviceGetAttribute(&cus, hipDeviceAttributeMultiprocessorCount, dev) != hipSuccess) { grid = -1; return; }
        if (hipFuncSetAttribute((const void*)mk_fwd, hipFuncAttributeMaxDynamicSharedMemorySize, LDS_BYTES) != hipSuccess) { fprintf(stderr, "hipFuncSetAttribute failed\n"); grid = -1; return; }
        if (ws_size < WS_END) { fprintf(stderr, "ws too small: %zu\n", ws_size); grid = -1; return; }
        grid = cus;
    }
    if (grid < 0) return;
    (void)hipMemsetAsync((char*)d_ws + WS_CTL, 0, CTL_ZERO_BYTES, stream);
    Args a{};
    for (int i = 0; i < 15; ++i) a.in[i] = (const float*)d_in[i];
    a.out = (float*)d_out; a.ws = (unsigned char*)d_ws;
    launch_mk(a, 0, 13, 0, grid, stream);
}
```

```cpp
#include <hip/hip_runtime.h>
#include <cstdio>
#include <cstdint>
#include <math.h>
#define PROBE_ID 0
#ifndef PROBE_ID
#define PROBE_ID 0
#endif
#ifndef PROBE_T
#define PROBE_T 0
#endif
#ifndef PROBE_OFF
#define PROBE_OFF 0
#define PROBE_SPAN 100
#endif

#define GEMM_TS_B() do { if (PROBE_T >= 71 && PROBE_T <= 72 && blockIdx.x == 0 && threadIdx.x == 0) ((volatile __attribute__((address_space(3))) unsigned*)(lds + 131392))[16] = (unsigned)__builtin_amdgcn_s_memrealtime(); } while (0)
#define GEMM_TS_E(k) do { if (PROBE_T == (k) && blockIdx.x == 0 && threadIdx.x == 0) { volatile __attribute__((address_space(3))) unsigned* m_ = (volatile __attribute__((address_space(3))) unsigned*)(lds + 131392); m_[17] += (unsigned)__builtin_amdgcn_s_memrealtime() - m_[16]; } } while (0)
namespace pg8 {
#define PG8_LAS __attribute__((address_space(3)))
typedef unsigned short bf16_t;
typedef short bf16x8 __attribute__((ext_vector_type(8)));
typedef float f32x4 __attribute__((ext_vector_type(4)));
typedef unsigned u32x4 __attribute__((ext_vector_type(4)));
constexpr int BM = 256, BK = 64, HALF = 128, HTB = HALF * BK * 2  , STAGE_BYTES = 8 * HTB, NXCD = 8, WGM = 8;

__host__ __device__ __forceinline__ int lds_byte(int r, int c) { const int st = (r >> 4) * 2 + (c >> 5), rr = r & 15, cc = c & 31, ob = rr * 64 + cc * 2; return st * 1024 + (ob ^ (((ob >> 9) & 1) << 5)); }
__host__ __device__ __forceinline__ void stage_rc(int b, int& R, int& C) { const int st = b / 1024, sb = b % 1024, swz = sb ^ (((sb >> 9) & 1) << 5); R = (st >> 1) * 16 + swz / 64; C = (st & 1) * 32 + (swz % 64) / 2; }
__host__ __device__ __forceinline__ int perm32(int rho) { const int n = rho >> 4, i = rho & 15; return 8 * (i >> 2) + 4 * n + (i & 3); }

struct Unit { int pm, pn; };
struct Gemm { const bf16_t* A; const bf16_t* Bt; int M, N, K; };

struct StaticOrder {
    int nM, nN, nwg, G, c;
    __host__ __device__ void init(int M, int N, int G_, int c_) { nM = M / BM; nN = N / BM; nwg = nM * nN; G = G_; c = c_; }
    __host__ __device__ bool next(int i, Unit& u) const {
        const long L = (long)i * G + c; if (L >= nwg) return false;
        int wgid = (int)L; { const int q = nwg / NXCD, r = nwg % NXCD, xcd = wgid % NXCD, off = wgid / NXCD; wgid = (xcd < r ? xcd * (q + 1) : r * (q + 1) + (xcd - r) * q) + off; }
        const int nig = WGM * nN, gid = wgid / nig, fm = gid * WGM, gsz = (nM - fm) < WGM ? (nM - fm) : WGM;
        u.pm = fm + ((wgid % nig) % gsz); u.pn = (wgid % nig) / gsz; return true;
    }
    __device__ __forceinline__ void a_ready(const Unit&) const {}
    __device__ __forceinline__ void done(const Unit&) const {}
};

__device__ __forceinline__ unsigned cvt_pk_bf16(float lo, float hi) { unsigned r; asm volatile("v_cvt_pk_bf16_f32 %0, %1, %2" : "=v"(r) : "v"(lo), "v"(hi)); return r; }

typedef float f32x2 __attribute__((ext_vector_type(2)));
constexpr int PLD_ = 3840;
struct EpiProj {
    static constexpr bool PERM = true, AFTER_DRAIN = false;
    bf16_t* O; float qscale;
    __device__ __forceinline__ void operator()(const f32x4 (&acc)[2][2][4][2], const Unit& u, int wr, int wc, int fr, int fq) const {
        const int row0 = u.pm * BM + wr * 64 + fr; const int colt = u.pn * BM;
        const float sc = (u.pn == 11) ? qscale : 1.f;
        const int col0 = colt + wc * 32 + 8 * fq;
#pragma unroll
        for (int ai = 0; ai < 2; ++ai)
#pragma unroll
            for (int m = 0; m < 4; ++m) { bf16_t* rowp = O + (size_t)(row0 + ai * HALF + m * 16) * PLD_ + col0;
#pragma unroll
                for (int bj = 0; bj < 2; ++bj) { f32x4 v0 = acc[ai][bj][m][0] * sc, v1 = acc[ai][bj][m][1] * sc;
                    u32x4 w; w.x = cvt_pk_bf16(v0[0], v0[1]); w.y = cvt_pk_bf16(v0[2], v0[3]); w.z = cvt_pk_bf16(v1[0], v1[1]); w.w = cvt_pk_bf16(v1[2], v1[3]);
                    *(u32x4*)(rowp + bj * HALF) = w; } }
    }
};
struct EpiZ {
    static constexpr bool PERM = true, AFTER_DRAIN = false;
    bf16_t* Z; const bf16_t* Hres; float alpha;
    __device__ __forceinline__ void operator()(const f32x4 (&acc)[2][2][4][2], const Unit& u, int wr, int wc, int fr, int fq) const {
        const int row0 = u.pm * BM + wr * 64 + fr, col0 = u.pn * BM + wc * 32 + 8 * fq;
#pragma unroll
        for (int ai = 0; ai < 2; ++ai) {
            u32x4 hv[4][2];
#pragma unroll
            for (int m = 0; m < 4; ++m)
#pragma unroll
                for (int bj = 0; bj < 2; ++bj) hv[m][bj] = *(const u32x4*)(Hres + (size_t)(row0 + ai * HALF + m * 16) * 1024 + col0 + bj * HALF);
#pragma unroll
            for (int m = 0; m < 4; ++m)
#pragma unroll
                for (int bj = 0; bj < 2; ++bj) { const u32x4 h4 = hv[m][bj];
                    const f32x4 v0 = acc[ai][bj][m][0], v1 = acc[ai][bj][m][1];
                    u32x4 w;
                    w.x = cvt_pk_bf16(__uint_as_float(h4.x << 16) * alpha + v0[0], __uint_as_float(h4.x & 0xffff0000u) * alpha + v0[1]);
                    w.y = cvt_pk_bf16(__uint_as_float(h4.y << 16) * alpha + v0[2], __uint_as_float(h4.y & 0xffff0000u) * alpha + v0[3]);
                    w.z = cvt_pk_bf16(__uint_as_float(h4.z << 16) * alpha + v1[0], __uint_as_float(h4.z & 0xffff0000u) * alpha + v1[1]);
                    w.w = cvt_pk_bf16(__uint_as_float(h4.w << 16) * alpha + v1[2], __uint_as_float(h4.w & 0xffff0000u) * alpha + v1[3]);
                    *(u32x4*)(Z + (size_t)(row0 + ai * HALF + m * 16) * 1024 + col0 + bj * HALF) = w; }
        }
    }
};
template <class Epi, class Sched, bool ALIGN_EPI = false, bool SP2 = false>
__device__ __forceinline__ void gemm_phase(PG8_LAS unsigned char* lds, const Gemm g, const Sched& S, const Epi& E) {
    const int tid = threadIdx.x, wid = __builtin_amdgcn_readfirstlane(tid >> 6), lane = tid & 63, wr = wid >> 2, wc = wid & 3, fr = lane & 15, fq = lane >> 4;
    const int K = g.K, nt = K / BK;
    unsigned voffA[2], voffB[2];
#pragma unroll
    for (int i = 0; i < 2; ++i) { int R, C; stage_rc(tid * 16 + i * 8192, R, C); const int Rb = Epi::PERM ? ((R & ~31) + perm32(R & 31)) : R;
        voffA[i] = (unsigned)(R * K + C) * 2u; voffB[i] = (unsigned)(Rb * K + C) * 2u; }
    const size_t kstep = (size_t)(BK * 2);
    const size_t hstep = (size_t)HALF * K * 2;
    const size_t tstep = 2 * hstep;
    const unsigned ldsw = (unsigned)wid * 1024u;
    const int aoff = lds_byte(wr * 64 + fr, fq * 8), boff = lds_byte(wc * 32 + fr, fq * 8);
#define PG8_SA(b, h) (((b) * 2 + (h)) * HTB)
#define PG8_SB(b, h) ((4 + (b) * 2 + (h)) * HTB)
#define PG8_STAGE(bufoff, gbase, voff) do { _Pragma("unroll") for (int _i = 0; _i < 2; ++_i) \
        __builtin_amdgcn_global_load_lds((const unsigned*)((const char*)(gbase) + (voff)[_i]), (PG8_LAS unsigned*)(lds + (bufoff) + ldsw + _i * 8192), 16, 0, 0); } while (0)
#define PG8_LDA(dst, b, h) do { _Pragma("unroll") for (int m = 0; m < 4; ++m) _Pragma("unroll") for (int k = 0; k < 2; ++k) dst[m][k] = *(const PG8_LAS bf16x8*)(lds + PG8_SA(b, h) + aoff + m * 2048 + k * 1024); } while (0)
#define PG8_LDB(dst, b, h) do { _Pragma("unroll") for (int n = 0; n < 2; ++n) _Pragma("unroll") for (int k = 0; k < 2; ++k) dst[n][k] = *(const PG8_LAS bf16x8*)(lds + PG8_SB(b, h) + boff + n * 2048 + k * 1024); } while (0)
#define PG8_MMA(ai, bj, At, Bt) do { __builtin_amdgcn_s_setprio(1); _Pragma("unroll") for (int m = 0; m < 4; ++m) _Pragma("unroll") for (int n = 0; n < 2; ++n) _Pragma("unroll") for (int k = 0; k < 2; ++k) \
        acc[ai][bj][m][n] = __builtin_amdgcn_mfma_f32_16x16x32_bf16(Bt[n][k], At[m][k], acc[ai][bj][m][n], 0, 0, 0); __builtin_amdgcn_s_setprio(0); } while (0)
#define PG8_WAIT_V(n) asm volatile("s_waitcnt vmcnt(" #n ")" ::: "memory")
#define PG8_WAIT_L(n) asm volatile("s_waitcnt lgkmcnt(" #n ")" ::: "memory")
#define PG8_BAR __builtin_amdgcn_s_barrier()
#define PG8_SCHED __builtin_amdgcn_sched_barrier(0)
    Unit cur, nxt; int ui = 0;
    if (!S.next(0, cur)) return;
    f32x4 acc[2][2][4][2];
#pragma unroll
    for (int a = 0; a < 2; ++a)
#pragma unroll
        for (int b = 0; b < 2; ++b)
#pragma unroll
            for (int m = 0; m < 4; ++m)
#pragma unroll
                for (int n = 0; n < 2; ++n) acc[a][b][m][n] = (f32x4){0.f, 0.f, 0.f, 0.f};
    bf16x8 At[4][2], B0[2][2], B1[2][2];
    const char* cA = (const char*)g.A + (size_t)cur.pm * tstep; const char* cB = (const char*)g.Bt + (size_t)cur.pn * tstep;
    S.a_ready(cur);
    if constexpr (SP2) {
        PG8_STAGE(PG8_SB(0, 0), cB, voffB); PG8_STAGE(PG8_SB(0, 1), cB + hstep, voffB); PG8_STAGE(PG8_SA(0, 0), cA, voffA); PG8_STAGE(PG8_SA(0, 1), cA + hstep, voffA);
        if (wr == 1) PG8_BAR;
        PG8_WAIT_V(2); PG8_BAR;
        PG8_STAGE(PG8_SB(1, 0), cB + kstep, voffB); PG8_STAGE(PG8_SA(1, 0), cA + kstep, voffA); PG8_STAGE(PG8_SB(1, 1), cB + hstep + kstep, voffB);
        PG8_WAIT_V(6); PG8_BAR;
    } else {
        PG8_STAGE(PG8_SB(0, 0), cB, voffB); PG8_STAGE(PG8_SA(0, 0), cA, voffA); PG8_STAGE(PG8_SB(0, 1), cB + hstep, voffB); PG8_STAGE(PG8_SA(0, 1), cA + hstep, voffA);
        if (wr == 1) PG8_BAR;
        PG8_WAIT_V(4); PG8_BAR;
        PG8_STAGE(PG8_SB(1, 0), cB + kstep, voffB); PG8_STAGE(PG8_SA(1, 0), cA + kstep, voffA); PG8_STAGE(PG8_SB(1, 1), cB + hstep + kstep, voffB);
        PG8_WAIT_V(6); PG8_BAR;
    }
    for (;;) {
        const bool has_next = S.next(ui + 1, nxt);
        const char* nA = has_next ? (const char*)g.A + (size_t)nxt.pm * tstep : cA; const char* nB = has_next ? (const char*)g.Bt + (size_t)nxt.pn * tstep : cB;
        GEMM_TS_B();
        for (int t = 0; t < nt; t += 2) {
            const bool last = (t == nt - 2);
            const char* a1 = cA + (size_t)(t + 1) * kstep;
            const char* a2 = last ? nA : cA + (size_t)(t + 2) * kstep; const char* b2 = last ? nB : cB + (size_t)(t + 2) * kstep;
            const char* a3 = a2 + kstep; const char* b3 = b2 + kstep;
            if (last && has_next) S.a_ready(nxt);
            if constexpr (SP2) {
            PG8_LDB(B0, 0, 0); PG8_LDB(B1, 0, 1); PG8_SCHED; PG8_LDA(At, 0, 0); PG8_STAGE(PG8_SA(1, 1), a1 + hstep, voffA);
            PG8_WAIT_V(8); PG8_WAIT_L(0); PG8_BAR; PG8_MMA(0, 0, At, B0); PG8_MMA(0, 1, At, B1); PG8_BAR; PG8_SCHED;
            PG8_LDA(At, 0, 1); PG8_STAGE(PG8_SB(0, 0), b2, voffB); PG8_STAGE(PG8_SB(0, 1), b2 + hstep, voffB); PG8_STAGE(PG8_SA(0, 0), a2, voffA);
            PG8_WAIT_V(8); PG8_WAIT_L(0); PG8_BAR; PG8_MMA(1, 0, At, B0); PG8_MMA(1, 1, At, B1); PG8_BAR; PG8_SCHED;
            PG8_LDB(B0, 1, 0); PG8_LDB(B1, 1, 1); PG8_SCHED; PG8_LDA(At, 1, 0); PG8_STAGE(PG8_SA(0, 1), a2 + hstep, voffA);
            PG8_WAIT_V(8); PG8_WAIT_L(0); PG8_BAR; PG8_MMA(0, 0, At, B0); PG8_MMA(0, 1, At, B1); PG8_BAR; PG8_SCHED;
            PG8_LDA(At, 1, 1); PG8_STAGE(PG8_SB(1, 0), b3, voffB); PG8_STAGE(PG8_SB(1, 1), b3 + hstep, voffB); PG8_STAGE(PG8_SA(1, 0), a3, voffA);
            PG8_WAIT_V(8); PG8_WAIT_L(0); PG8_BAR; PG8_MMA(1, 0, At, B0); PG8_MMA(1, 1, At, B1); PG8_BAR; PG8_SCHED;
            } else {
            PG8_LDB(B0, 0, 0); PG8_SCHED; PG8_LDA(At, 0, 0); PG8_STAGE(PG8_SA(1, 1), a1 + hstep, voffA);
            PG8_WAIT_L(8); PG8_BAR; PG8_WAIT_L(0); PG8_MMA(0, 0, At, B0); PG8_BAR; PG8_SCHED;
            PG8_LDB(B1, 0, 1); PG8_STAGE(PG8_SB(0, 0), b2, voffB);
            PG8_BAR; PG8_WAIT_L(0); PG8_MMA(0, 1, At, B1); PG8_BAR;
            PG8_LDA(At, 0, 1); PG8_STAGE(PG8_SA(0, 0), a2, voffA);
            PG8_BAR; PG8_WAIT_L(0); PG8_MMA(1, 0, At, B0); PG8_BAR; PG8_SCHED;
            PG8_STAGE(PG8_SB(0, 1), b2 + hstep, voffB);
            PG8_WAIT_V(6); PG8_BAR; PG8_MMA(1, 1, At, B1); PG8_BAR;
            PG8_LDB(B0, 1, 0); PG8_SCHED; PG8_LDA(At, 1, 0); PG8_STAGE(PG8_SA(0, 1), a2 + hstep, voffA);
            PG8_WAIT_L(8); PG8_BAR; PG8_WAIT_L(0); PG8_MMA(0, 0, At, B0); PG8_BAR; PG8_SCHED;
            PG8_LDB(B1, 1, 1); PG8_STAGE(PG8_SB(1, 0), b3, voffB);
            PG8_BAR; PG8_WAIT_L(0); PG8_MMA(0, 1, At, B1); PG8_BAR;
            PG8_LDA(At, 1, 1); PG8_STAGE(PG8_SA(1, 0), a3, voffA);
            PG8_BAR; PG8_WAIT_L(0); PG8_MMA(1, 0, At, B0); PG8_BAR; PG8_SCHED;
            PG8_STAGE(PG8_SB(1, 1), b3 + hstep, voffB);
            PG8_WAIT_V(6); PG8_BAR; PG8_MMA(1, 1, At, B1); PG8_BAR;
            }
        }
        GEMM_TS_E(71); GEMM_TS_B();
        if constexpr (ALIGN_EPI) { if (wr == 0) PG8_BAR; }
        if constexpr (!Epi::AFTER_DRAIN) { E(acc, cur, wr, wc, fr, fq); S.done(cur); }
        GEMM_TS_E(72);
        if (!has_next) break;
#pragma unroll
        for (int a = 0; a < 2; ++a)
#pragma unroll
            for (int b = 0; b < 2; ++b)
#pragma unroll
                for (int m = 0; m < 4; ++m)
#pragma unroll
                    for (int n = 0; n < 2; ++n) acc[a][b][m][n] = (f32x4){0.f, 0.f, 0.f, 0.f};
        cur = nxt; cA = nA; cB = nB; ++ui;
        if constexpr (ALIGN_EPI) { if (wr == 1) PG8_BAR; }
    }
    PG8_WAIT_V(0);
    if constexpr (!ALIGN_EPI) { if (wr == 0) PG8_BAR; }
    PG8_BAR;
    if constexpr (Epi::AFTER_DRAIN) { E.fused(acc, cur, wr, wc, fr, fq, lds, wid, lane); S.done(cur); }
#undef PG8_SA
#undef PG8_SB
#undef PG8_STAGE
#undef PG8_LDA
#undef PG8_LDB
#undef PG8_MMA
#undef PG8_WAIT_V
#undef PG8_WAIT_L
#undef PG8_BAR
#undef PG8_SCHED
}
}


typedef unsigned short bf16_t;
__device__ __forceinline__ float bf2f(bf16_t b) { return __uint_as_float(((unsigned)b) << 16); }
typedef float f32x2_cv __attribute__((ext_vector_type(2))); typedef __bf16 bf16x2_cv __attribute__((ext_vector_type(2)));
__device__ __forceinline__ unsigned pk2(float lo, float hi) { f32x2_cv v = {lo, hi}; bf16x2_cv b = __builtin_convertvector(v, bf16x2_cv); return __builtin_bit_cast(unsigned, b); }
__device__ __forceinline__ bf16_t f2bf(float f) { return (bf16_t)(pk2(f, 0.f) & 0xffffu); }
__device__ __forceinline__ float sigmoid_f(float x) { return __builtin_amdgcn_rcpf(1.f + __builtin_amdgcn_exp2f(x * -1.4426950408889634f)); }
__device__ __forceinline__ float silu_f(float x) { return x * sigmoid_f(x); }
__device__ __forceinline__ float wave_sum(float v) {
#pragma unroll
    for (int o = 1; o < 64; o <<= 1) v += __shfl_xor(v, o);
    return v;
}
__device__ __forceinline__ float wave_max(float v) {
#pragma unroll
    for (int o = 1; o < 64; o <<= 1) v = fmaxf(v, __shfl_xor(v, o));
    return v;
}

constexpr int NB = 4, L = 8192, M = NB * L, D = 1024, NIN = 3844, PLD = 3840;
constexpr int C_SZ = 0, C_XBC = 256, C_HQ = 768, C_HF = 1024, C_HI = 1280, C_HG = 1536, C_RQ = 1792, C_RK = 2048, C_RV = 2304, C_RG = 2560,
              C_MQ = 2816, C_MK = 3072, C_MV = 3328, C_MG = 3584;
constexpr float LN_EPS = 1e-5f, RMS_EPS = 1e-6f;
#define ALPHA 1.4142135623730951f
constexpr float QC2 = 0.125f * 1.4426950408889634f;


#include <hip/hip_bf16.h>
#include <cmath>
namespace attn_body {
using bf16=__hip_bfloat16;
using bf16x8=__attribute__((ext_vector_type(8)))short;
using s16x4=__attribute__((ext_vector_type(4)))short;
using f32x16=__attribute__((ext_vector_type(16)))float;
using u32x4=__attribute__((ext_vector_type(4)))unsigned;
constexpr int BATCH=4,NHEAD=4,SEQ=8192,D=64,DM=3840,DMO=1024,OCOL=768;
constexpr int NW=8,QBLK=32,QB=QBLK*NW,KVBLK=64,NQB=SEQ/QB;
constexpr int ATTN_PITCH=DM, ATTN_UNIT_ROWS=QB;
__device__ __forceinline__ int crow(int r,int hi){return (r&3)+8*(r>>2)+4*hi;}
#define SBAR() __builtin_amdgcn_sched_barrier(0)
__device__ __forceinline__ void cmask(f32x16&p0,f32x16&p1,int jb,int qrel,int hi){
  const float NEG=-INFINITY; int kb=64*jb+4*hi;
  #pragma unroll
  for(int r=0;r<16;++r){int kv=kb+(r&3)+8*(r>>2); if(kv>qrel)p0[r]=NEG; if(kv+32>qrel)p1[r]=NEG;}
}

constexpr int NSLOT=4, SLOTB=8192;
constexpr int WSF=256; constexpr int LDS_K=0, LDS_V=NSLOT*SLOTB, LDS_WS=2*NSLOT*SLOTB, LDS_OST=LDS_WS+NW*WSF*4, LDS_BYTES=LDS_OST+NW*4096;
constexpr float C2=0.125f*1.4426950408889634f;
__device__ __forceinline__ void glds16(const void*gsrc,unsigned lds_dst){unsigned keep;
  asm volatile("s_mov_b32 %0, m0\n\ts_mov_b32 m0, %2\n\ts_nop 0\n\tglobal_load_lds_dwordx4 %1, off\n\ts_mov_b32 m0, %0":"=&s"(keep):"v"(gsrc),"s"(lds_dst):"memory");}
__device__ __forceinline__ float max3f(float a,float b,float c){float r;asm("v_max3_f32 %0, %1, %2, %3":"=v"(r):"v"(a),"v"(b),"v"(c));return r;}
__device__ __forceinline__ float max2f(float a,float b){float r;asm("v_max_f32_e32 %0, %1, %2":"=v"(r):"v"(a),"v"(b));return r;}
__device__ __forceinline__ float fadd_s(float a,float b){float r;asm("v_add_f32_e32 %0, %1, %2":"=v"(r):"v"(a),"v"(b));return r;}
__device__ __forceinline__ float fsub_s(float a,float b){float r;asm("v_sub_f32_e32 %0, %1, %2":"=v"(r):"v"(a),"v"(b));return r;}
typedef float f32x2_t __attribute__((ext_vector_type(2))); typedef __bf16 bf16x2_t __attribute__((ext_vector_type(2)));
__device__ __forceinline__ unsigned cvtpk_s(float lo,float hi){f32x2_t v={lo,hi};bf16x2_t b=__builtin_convertvector(v,bf16x2_t);return __builtin_bit_cast(unsigned,b);}
#define WAIT_BAR(N) asm volatile("s_waitcnt vmcnt(" #N ") lgkmcnt(0)\n\ts_barrier":::"memory")
#define LWAIT() asm volatile("s_waitcnt lgkmcnt(0)":::"memory")

__device__ __forceinline__ void qkt(f32x16&p0,f32x16&p1,const char*Kslot,const bf16x8*qr,int r32,int hi){
  const char*kb=Kslot+hi*1024+r32*16;
  #pragma unroll
  for(int d0=0;d0<4;++d0){
    const bf16x8 b0=*reinterpret_cast<const bf16x8*>(kb+d0*2048);
    const bf16x8 b1=*reinterpret_cast<const bf16x8*>(kb+d0*2048+512);
    p0=__builtin_amdgcn_mfma_f32_32x32x16_bf16(b0,qr[d0],p0,0,0,0);p1=__builtin_amdgcn_mfma_f32_32x32x16_bf16(b1,qr[d0],p1,0,0,0);}
}
typedef __attribute__((address_space(3))) const char* lds_cptr;
typedef short v4i16_t __attribute__((ext_vector_type(4)));
__device__ __forceinline__ void kload8(bf16x8*kf,lds_cptr kp){
  kf[0]=*(const __attribute__((address_space(3))) bf16x8*)(kp);      kf[1]=*(const __attribute__((address_space(3))) bf16x8*)(kp+512);
  kf[2]=*(const __attribute__((address_space(3))) bf16x8*)(kp+2048); kf[3]=*(const __attribute__((address_space(3))) bf16x8*)(kp+2560);
  kf[4]=*(const __attribute__((address_space(3))) bf16x8*)(kp+4096); kf[5]=*(const __attribute__((address_space(3))) bf16x8*)(kp+4608);
  kf[6]=*(const __attribute__((address_space(3))) bf16x8*)(kp+6144); kf[7]=*(const __attribute__((address_space(3))) bf16x8*)(kp+6656);
}
__device__ __forceinline__ void kload2(bf16x8*kf,lds_cptr kp,int j){ kf[2*j]=*(const __attribute__((address_space(3))) bf16x8*)(kp+j*2048); kf[2*j+1]=*(const __attribute__((address_space(3))) bf16x8*)(kp+j*2048+512); }
__device__ __forceinline__ s16x4 vtr(lds_cptr p){ return __builtin_bit_cast(s16x4,__builtin_amdgcn_ds_read_tr16_b64_v4i16((__attribute__((address_space(3))) v4i16_t*)p)); }
__device__ __forceinline__ float rowmax(const f32x16&p0,const f32x16&p1){
  float a=max3f(p0[0],p0[1],p1[0]),b=max3f(p0[2],p0[3],p1[1]);a=max3f(a,p1[2],p1[3]);
  #pragma unroll
  for(int r=4;r<16;r+=4){a=max3f(a,p0[r],p0[r+1]);b=max3f(b,p0[r+2],p0[r+3]);a=max3f(a,p1[r],p1[r+1]);b=max3f(b,p1[r+2],p1[r+3]);}
  const float m=max2f(a,b);
  auto rr=__builtin_amdgcn_permlane32_swap(__float_as_uint(m),__float_as_uint(m),false,false);
  return max2f(__uint_as_float(rr[0]),__uint_as_float(rr[1]));
}
__device__ __forceinline__ void pv(f32x16*o,int vb,bf16x8 pa0,bf16x8 pa1,bf16x8 pa2,bf16x8 pa3){
  #pragma unroll
  for(int d0=0;d0<2;++d0){s16x4 lo[4],hi[4];
    #pragma unroll
    for(int ks=0;ks<4;++ks){
      asm volatile("ds_read_b64_tr_b16 %0,%1 offset:%c2":"=&v"(lo[ks]):"v"(vb),"i"(d0*4096+ks*1024):"memory");
      asm volatile("ds_read_b64_tr_b16 %0,%1 offset:%c2":"=&v"(hi[ks]):"v"(vb),"i"(d0*4096+ks*1024+512):"memory");}
    asm volatile("s_waitcnt lgkmcnt(0)":::"memory");SBAR();
    #define PK(k) (bf16x8){lo[k][0],lo[k][1],lo[k][2],lo[k][3],hi[k][0],hi[k][1],hi[k][2],hi[k][3]}
    o[d0]=__builtin_amdgcn_mfma_f32_32x32x16_bf16(pa0,PK(0),o[d0],0,0,0);
    o[d0]=__builtin_amdgcn_mfma_f32_32x32x16_bf16(pa1,PK(1),o[d0],0,0,0);
    o[d0]=__builtin_amdgcn_mfma_f32_32x32x16_bf16(pa2,PK(2),o[d0],0,0,0);
    o[d0]=__builtin_amdgcn_mfma_f32_32x32x16_bf16(pa3,PK(3),o[d0],0,0,0);
    #undef PK
  }
}

#ifndef ATTN_STORE16
#define ATTN_STORE16(p,v) (*(u32x4*)(p)=(v))
#endif
struct AttnTensors { const bf16* Q; const bf16* K; const bf16* V; const bf16* G; bf16* O; const unsigned* SEL; bf16* PO; float* ML; };
template<int THRL,int MODE> __device__ __forceinline__ void attn_unit(int b,int h,int kblk,const AttnTensors&T,const unsigned*rows,int nrows,char*shm){
  const bf16*Q=T.Q; const bf16*__restrict__ K=T.K; const bf16*__restrict__ V=T.V;
  int tid_=threadIdx.x; asm volatile("":"+v"(tid_)); const int tid=tid_,lane=tid&63,r32=lane&31,hi=lane>>5; const int wid=__builtin_amdgcn_readfirstlane(tid>>6);
  const long rowbase=(long)b*SEQ; const int q0=kblk*QB; const int kbase=kblk*QB;
  const bf16*Kh=K+(rowbase+kbase)*DM+h*D,*Vh=V+(rowbase+kbase)*DM+h*D;
  const bf16*Qh=Q+rowbase*DM+h*D;
  const unsigned lds0=(unsigned)(uintptr_t)shm;
  float*wsf=(float*)(shm+LDS_WS)+wid*WSF;
  const bf16*ksrc=Kh+(long)lane*DM+wid*8;
  const bf16*vsrc=Vh+(long)(16*(wid&3)+(lane>>2))*DM+(wid>>2)*32+(lane&3)*8;
  const unsigned kdst=lds0+LDS_K+wid*1024, vdst=lds0+LDS_V+wid*1024;
  #define DMA_K(t,slot) glds16(ksrc+(long)(t)*KVBLK*DM,(unsigned)__builtin_amdgcn_readfirstlane(kdst+(slot)))
  #define DMA_V(t,slot) glds16(vsrc+(long)(t)*KVBLK*DM,(unsigned)__builtin_amdgcn_readfirstlane(vdst+(slot)))
  #define ATS_B() do{ if(PROBE_T>=51&&PROBE_T<=54&&MODE==1&&blockIdx.x==0&&threadIdx.x==0) ((volatile unsigned*)(shm+131392))[16]=(unsigned)__builtin_amdgcn_s_memrealtime(); }while(0)
  #define ATS_E(k) do{ if(PROBE_T==(k)&&MODE==1&&blockIdx.x==0&&threadIdx.x==0) ((volatile unsigned*)(shm+131392))[17]+=(unsigned)__builtin_amdgcn_s_memrealtime()-((volatile unsigned*)(shm+131392))[16]; }while(0)
  ATS_B();
  constexpr int NT=4;
  DMA_K(0,0);DMA_V(0,0);DMA_K(1,SLOTB);DMA_V(1,SLOTB);DMA_K(2,2*SLOTB);DMA_V(2,2*SLOTB);DMA_K(3,3*SLOTB);DMA_V(3,3*SLOTB);
  WAIT_BAR(0);
  unsigned rent_n=0u, rent_nn=0u; if(MODE==1){ const int q_=wid*QBLK+(tid&31); if(q_<nrows) rent_n=rows[q_]; if(q_+NW*QBLK<nrows) rent_nn=rows[q_+NW*QBLK]; }
  bf16x8 qn[4]; if(MODE==1){ const int q_=wid*QBLK+(tid&31); const int tq_=(q_<nrows)?(int)(rent_n&8191u):(kbase+QB); const bf16*Qn=Qh+(long)tq_*DM+((tid&63)>>5)*8;
    _Pragma("unroll") for(int d0=0;d0<4;++d0)qn[d0]=*reinterpret_cast<const bf16x8*>(&Qn[d0*16]); }
  ATS_E(54);
  for(int rt=wid; rt*QBLK<nrows; rt+=NW){
  ATS_B(); if(PROBE_T==55&&MODE==1&&blockIdx.x==0&&threadIdx.x==0) ((volatile unsigned*)(shm+131392))[17]+=100u;
  int tl_=tid; asm volatile("":"+v"(tl_)); const int lane=tl_&63,r32=lane&31,hi=lane>>5;
  const int vb0=(int)(lds0+LDS_V)+((lane>>4)&1)*32+(lane&3)*8+(4*hi+((lane&15)>>2))*64;
  const char*Kbase=shm+LDS_K; bf16x8 kf[8];
  const lds_cptr shm3=(lds_cptr)shm; const lds_cptr kp0=shm3+LDS_K+hi*1024+r32*16; const lds_cptr vp0=shm3+LDS_V+((lane>>4)&1)*32+(lane&3)*8+(4*hi+((lane&15)>>2))*64;
  const int qrel=rt*QBLK+r32;
  unsigned rent=0u; bool rvalid=true; int tq=q0+qrel;
  if(MODE==1){ rvalid=qrel<nrows; rent=rent_n; tq=rvalid?(int)(rent&8191u):(kbase+QB); rent_n=rent_nn; const int qn_=qrel+2*NW*QBLK; rent_nn=(qn_<nrows)?rows[qn_]:0u; }
  const bf16*Qw=Qh+(long)tq*DM;
  bf16x8 qr[4];
  #pragma unroll
  for(int d0=0;d0<4;++d0){ if(MODE==1) qr[d0]=qn[d0]; else qr[d0]=*reinterpret_cast<const bf16x8*>(&Qw[d0*16+hi*8]); }
  if(MODE==1){ const int qn2_=qrel+NW*QBLK; if(qn2_<nrows+QBLK){ const int tqn_=(qn2_<nrows)?(int)(rent_n&8191u):(kbase+QB); const bf16*Qn=Qh+(long)tqn_*DM+hi*8;
    _Pragma("unroll") for(int d0=0;d0<4;++d0)qn[d0]=*reinterpret_cast<const bf16x8*>(&Qn[d0*16]); } }
  float mhat=0.f,l_reg=0.f;f32x16 o[2];o[0]=f32x16{};o[1]=f32x16{};
  const float slope2=__uint_as_float(__builtin_amdgcn_readfirstlane(__float_as_uint(__builtin_amdgcn_exp2f(-2.f*(float)(h+1))*1.4426950408889634f)));
  #define CINIT(C0,C1,t) do{ const float b0_=__builtin_fmaf(slope2,(float)(kbase+64*(t)+4*hi-tq),-mhat); const float b1_=b0_+32.f*slope2; \
    _Pragma("unroll") for(int r=0;r<16;++r){ C0[r]=__builtin_fmaf(slope2,(float)((r&3)+8*(r>>2)),b0_); C1[r]=__builtin_fmaf(slope2,(float)((r&3)+8*(r>>2)),b1_);} }while(0)
  #define CMASK(P0,P1,t) do{ if(MODE==0){int jb_=(t)-(NT-4); if(jb_>=0)cmask(P0,P1,jb_,qrel,hi);} }while(0)
  bool resc=false;
  #define START(P0,P1) do{ const float rm=rowmax(P0,P1); resc=false; \
    { const float dl=(rm>-INFINITY)?rm:0.f; mhat=fadd_s(mhat,dl); \
      _Pragma("unroll") for(int r=0;r<16;++r){P0[r]=fsub_s(P0[r],dl);P1[r]=fsub_s(P1[r],dl);} } \
    _Pragma("unroll") for(int r=0;r<16;++r)P0[r]=__builtin_amdgcn_exp2f(P0[r]); }while(0)
  #define RESC() do{ if(resc){ asm volatile("s_waitcnt lgkmcnt(0)":::"memory"); \
      _Pragma("unroll") for(int d_=0;d_<2;++d_) _Pragma("unroll") for(int r=0;r<16;++r)o[d_][r]*=wsf[crow(r,hi)]; } }while(0)
  f32x16 pA0,pA1,pB0,pB1;
  int sl_prev=0,sl_cur=0,sl_next=SLOTB;
  #define ROT() do{sl_prev=sl_cur;sl_cur=sl_next;sl_next=(sl_next==(NSLOT-1)*SLOTB)?0:sl_next+SLOTB;}while(0)
  CINIT(pA0,pA1,0); qkt(pA0,pA1,Kbase,qr,r32,hi);asm volatile("s_nop 15\n\ts_nop 7":"+v"(pA0),"+v"(pA1));CMASK(pA0,pA1,0);
  START(pA0,pA1);
  _Pragma("unroll") for(int r=0;r<16;++r)pA1[r]=__builtin_amdgcn_exp2f(pA1[r]);
  ATS_E(51); ATS_B();
  ROT();
  kload8(kf,kp0+sl_cur);
  LWAIT();
  s16x4 vlo[8],vhi[8]; u32x4 pw0,pw1,pw2,pw3;
  #define PKW(P,B) cvtpk_s(P[B],P[B+1])
  #define PAF(k) __builtin_bit_cast(bf16x8,pw##k)
  #define VFR(i) (bf16x8){vlo[i][0],vlo[i][1],vlo[i][2],vlo[i][3],vhi[i][0],vhi[i][1],vhi[i][2],vhi[i][3]}
  #define PIN(x) asm volatile("":"+v"(x))
  #define MX3(a,b,c) __builtin_fmaxf(__builtin_fmaxf((a),(b)),(c))
  #define GAPA(MF,A0,A1,A2,A3,W0,W1,PW) do{ MF; sacc+=A0; sacc+=A1; sacc+=A2; sacc+=A3; PIN(sacc); W0; W1; PIN(PW); SBAR(); }while(0)
  #define EX(v) __builtin_amdgcn_exp2f(v)
  #define GAPB(MF,X,B) do{ MF; X[B]=EX(X[B]); X[B+1]=EX(X[B+1]); X[B+2]=EX(X[B+2]); X[B+3]=EX(X[B+3]); PIN(X); SBAR(); }while(0)
  #define VRD(i) do{ vlo[i]=vtr(vp_+(((i)>>2)*4096+((i)&3)*1024)); vhi[i]=vtr(vp_+(((i)>>2)*4096+((i)&3)*1024+512)); }while(0)
  #define KRD(G,j) do{ if(G){ kload2(kf,kp0+sl_next,j); SBAR(); } }while(0)
  #define STEP(C0,C1,P0,P1,t,GK,GV,GL) do{ SBAR(); CINIT(C0,C1,t); \
    const lds_cptr vp_=vp0+sl_prev; \
    VRD(0); SBAR(); float sacc=(P0[0]+P0[1]); \
    GAPA(C0=__builtin_amdgcn_mfma_f32_32x32x16_bf16(kf[0],qr[0],C0,0,0,0), P0[2],P0[3],P0[4],P0[5],     pw0[0]=PKW(P0,0), pw0[1]=PKW(P0,2), pw0); \
    VRD(4); SBAR(); GAPA(C1=__builtin_amdgcn_mfma_f32_32x32x16_bf16(kf[1],qr[0],C1,0,0,0), P0[6],P0[7],P0[8],P0[9],     pw0[2]=PKW(P0,4), pw0[3]=PKW(P0,6), pw0); \
    VRD(1); SBAR(); GAPA(C0=__builtin_amdgcn_mfma_f32_32x32x16_bf16(kf[2],qr[1],C0,0,0,0),   P0[10],P0[11],P0[12],P0[13], pw1[0]=PKW(P0,8), pw1[1]=PKW(P0,10), pw1); \
    VRD(5); SBAR(); GAPA(C1=__builtin_amdgcn_mfma_f32_32x32x16_bf16(kf[3],qr[1],C1,0,0,0),   P0[14],P0[15],P1[0],P1[1],   pw1[2]=PKW(P0,12),pw1[3]=PKW(P0,14), pw1); \
    VRD(2); SBAR(); GAPA(C0=__builtin_amdgcn_mfma_f32_32x32x16_bf16(kf[4],qr[2],C0,0,0,0),   P1[2],P1[3],P1[4],P1[5],     pw2[0]=PKW(P1,0), pw2[1]=PKW(P1,2), pw2); \
    VRD(6); SBAR(); GAPA(C1=__builtin_amdgcn_mfma_f32_32x32x16_bf16(kf[5],qr[2],C1,0,0,0),   P1[6],P1[7],P1[8],P1[9],     pw2[2]=PKW(P1,4), pw2[3]=PKW(P1,6), pw2); \
    VRD(3); SBAR(); GAPA(C0=__builtin_amdgcn_mfma_f32_32x32x16_bf16(kf[6],qr[3],C0,0,0,0),   P1[10],P1[11],P1[12],P1[13], pw3[0]=PKW(P1,8), pw3[1]=PKW(P1,10), pw3); \
    VRD(7); SBAR(); GAPA(C1=__builtin_amdgcn_mfma_f32_32x32x16_bf16(kf[7],qr[3],C1,0,0,0),   P1[14],P1[15],0.f,0.f,       pw3[2]=PKW(P1,12),pw3[3]=PKW(P1,14), pw3); \
    l_reg+=sacc; \
    if(GK){DMA_K((t)+3,sl_cur);} if(GV){DMA_V((t)+1,sl_next);} \
    CMASK(C0,C1,t); \
    { float a=MX3(C0[0],C0[1],C1[0]),b=MX3(C0[2],C0[3],C1[1]); a=MX3(a,C1[2],C1[3]); \
      _Pragma("unroll") for(int r=4;r<16;r+=4){a=MX3(a,C0[r],C0[r+1]);b=MX3(b,C0[r+2],C0[r+3]);a=MX3(a,C1[r],C1[r+1]);b=MX3(b,C1[r+2],C1[r+3]);} \
      float rm=__builtin_fmaxf(a,b); { auto rr=__builtin_amdgcn_permlane32_swap(__float_as_uint(rm),__float_as_uint(rm),false,false); rm=__builtin_fmaxf(__uint_as_float(rr[0]),__uint_as_float(rr[1])); } \
      resc=false; \
      if(__builtin_expect(__any(rm>(float)THRL),0)){ const float dl=__builtin_fmaxf(rm,0.f); mhat+=dl; \
        _Pragma("unroll") for(int r=0;r<16;++r){C0[r]-=dl;C1[r]-=dl;} \
        const float f=__builtin_amdgcn_exp2f(-dl); l_reg*=f; if(hi==0)wsf[r32]=f; resc=true; } } \
    SBAR(); \
    GAPB(o[0]=__builtin_amdgcn_mfma_f32_32x32x16_bf16(PAF(0),VFR(0),o[0],0,0,0), C0,0); \
    GAPB(o[1]=__builtin_amdgcn_mfma_f32_32x32x16_bf16(PAF(0),VFR(4),o[1],0,0,0), C0,4); \
    KRD(GL,0); GAPB(o[0]=__builtin_amdgcn_mfma_f32_32x32x16_bf16(PAF(1),VFR(1),o[0],0,0,0), C0,8); \
    KRD(GL,1); GAPB(o[1]=__builtin_amdgcn_mfma_f32_32x32x16_bf16(PAF(1),VFR(5),o[1],0,0,0), C0,12); \
    KRD(GL,2); GAPB(o[0]=__builtin_amdgcn_mfma_f32_32x32x16_bf16(PAF(2),VFR(2),o[0],0,0,0), C1,0); \
    KRD(GL,3); GAPB(o[1]=__builtin_amdgcn_mfma_f32_32x32x16_bf16(PAF(2),VFR(6),o[1],0,0,0), C1,4); \
    GAPB(o[0]=__builtin_amdgcn_mfma_f32_32x32x16_bf16(PAF(3),VFR(3),o[0],0,0,0), C1,8); \
    GAPB(o[1]=__builtin_amdgcn_mfma_f32_32x32x16_bf16(PAF(3),VFR(7),o[1],0,0,0), C1,12); \
    }while(0)
  int t=1;
  #undef CMASK
  #define CMASK(P0,P1,t) do{}while(0)
  for(;t+5<NT;t+=2){
    STEP(pB0,pB1,pA0,pA1,t,false,false,true);     LWAIT(); RESC(); ROT();
    STEP(pA0,pA1,pB0,pB1,t+1,false,false,true);   LWAIT(); RESC(); ROT();
  }
  #undef CMASK
  #define CMASK(P0,P1,t) do{ if(MODE==0){int jb_=(t)-(NT-4); if(jb_>=0)cmask(P0,P1,jb_,qrel,hi);} }while(0)
  #define ENDW(tt) LWAIT()
  for(;t+1<NT;t+=2){
    STEP(pB0,pB1,pA0,pA1,t,false,false,(t+1<NT));       ENDW(t);   RESC(); ROT();
    STEP(pA0,pA1,pB0,pB1,t+1,false,false,(t+2<NT));     ENDW(t+1); RESC(); ROT();
  }
  STEP(pB0,pB1,pA0,pA1,NT-1,false,false,false); RESC();
  ATS_E(52); ATS_B();
  { float sacc=pB0[0]+pB0[1]; _Pragma("unroll") for(int r=2;r<16;++r)sacc+=pB0[r]; _Pragma("unroll") for(int r=0;r<16;++r)sacc+=pB1[r]; l_reg+=sacc;
    pw0=(u32x4){PKW(pB0,0),PKW(pB0,2),PKW(pB0,4),PKW(pB0,6)};pw1=(u32x4){PKW(pB0,8),PKW(pB0,10),PKW(pB0,12),PKW(pB0,14)};pw2=(u32x4){PKW(pB1,0),PKW(pB1,2),PKW(pB1,4),PKW(pB1,6)};pw3=(u32x4){PKW(pB1,8),PKW(pB1,10),PKW(pB1,12),PKW(pB1,14)};
    SBAR(); pv(o,vb0+sl_cur,PAF(0),PAF(1),PAF(2),PAF(3)); }
  #undef PKW
  #undef PAF
  #undef VFR
  #undef PIN
  #undef MX3
  #undef GAPA
  #undef GAPB
  #undef EX
  #undef VRD
  #undef KRD
  #undef STEP
  #undef ENDW
  {auto rr=__builtin_amdgcn_permlane32_swap(__float_as_uint(l_reg),__float_as_uint(l_reg),false,false);l_reg=__uint_as_float(rr[0])+__uint_as_float(rr[1]);}
  const long bh=(long)(b*NHEAD+h);
  bf16*stg=(bf16*)(shm+LDS_OST)+wid*2048;
  if(MODE==1){
    if(hi==0){ wsf[64+r32]=__uint_as_float(rvalid?(rent|0x10000u):0u);
      if(rvalid){ float2 ml; ml.x=mhat; ml.y=l_reg; *(float2*)(T.ML+((bh*SEQ+tq)*3+(long)((rent>>13)&3u))*2)=ml; } }
    #pragma unroll
    for(int r=0;r<16;++r){const int orow=crow(r,hi);
      #pragma unroll
      for(int d0=0;d0<2;++d0)stg[orow*64+d0*32+r32]=__float2bfloat16(o[d0][r]);}
    asm volatile("s_waitcnt lgkmcnt(0)":::"memory");
    #pragma unroll
    for(int i=0;i<4;++i){const int row=i*8+(lane>>3),ch=lane&7; const unsigned e=__float_as_uint(wsf[64+row]);
      const u32x4 v=*(const u32x4*)(stg+row*64+ch*8);
      if(e&0x10000u) *(u32x4*)(T.PO+((bh*SEQ+(long)(e&8191u))*3+(long)((e>>13)&3u))*64+ch*8)=v; }
  } else {
    u32x4 pvv[4][3], gvv[4];
    bf16*Ow=T.O+(rowbase+q0+rt*QBLK)*DMO+OCOL+h*D; const bf16*Gw=T.G+(rowbase+q0+rt*QBLK)*DM+h*D;
    #pragma unroll
    for(int i=0;i<4;++i){const int row=i*8+(lane>>3),ch=lane&7;
      const bf16*pp=T.PO+((bh*SEQ+(long)(q0+rt*QBLK+row))*3)*64+ch*8;
      #pragma unroll
      for(int k=0;k<3;++k) pvv[i][k]=*(const u32x4*)(pp+k*64);
      gvv[i]=*(const u32x4*)(Gw+(long)row*DM+ch*8); }
    { const unsigned msk=T.SEL[bh*SEQ+tq];
      float2 mlv[3];
      #pragma unroll
      for(int k=0;k<3;++k) mlv[k]=*(const float2*)(T.ML+((bh*SEQ+tq)*3+k)*2);
      const int nv=__builtin_popcount(msk);
      float mk[3],lk[3]; float mt=mhat;
      #pragma unroll
      for(int k=0;k<3;++k){ const bool ok=k<nv; mk[k]=ok?mlv[k].x:-INFINITY; lk[k]=ok?mlv[k].y:0.f; mt=__builtin_fmaxf(mt,mk[k]); }
      const float so=__builtin_amdgcn_exp2f(mhat-mt); float lt=l_reg*so; float sk[3];
      #pragma unroll
      for(int k=0;k<3;++k){ sk[k]=(k<nv)?__builtin_amdgcn_exp2f(mk[k]-mt):0.f; lt+=lk[k]*sk[k]; }
      const float inv=1.f/lt;
      if(hi==0){ wsf[32+r32]=so*inv; wsf[64+3*r32+0]=sk[0]*inv; wsf[64+3*r32+1]=sk[1]*inv; wsf[64+3*r32+2]=sk[2]*inv; } }
    asm volatile("s_waitcnt lgkmcnt(0)":::"memory");
    #pragma unroll
    for(int r=0;r<16;++r){const int orow=crow(r,hi); const float sc=wsf[32+orow];
      #pragma unroll
      for(int d0=0;d0<2;++d0)stg[orow*64+d0*32+r32]=__float2bfloat16(o[d0][r]*sc);}
    asm volatile("s_waitcnt lgkmcnt(0)":::"memory");
    #pragma unroll
    for(int i=0;i<4;++i){const int row=i*8+(lane>>3),ch=lane&7;
      const u32x4 xs=*(const u32x4*)(stg+row*64+ch*8);
      float x[8];
      #pragma unroll
      for(int e=0;e<4;++e){ x[2*e]=__uint_as_float(xs[e]<<16); x[2*e+1]=__uint_as_float(xs[e]&0xffff0000u); }
      #pragma unroll
      for(int k=0;k<3;++k){ const float wk=wsf[64+3*row+k];
        if(wk!=0.f){ const u32x4 pv=pvv[i][k];
          #pragma unroll
          for(int e=0;e<4;++e){ x[2*e]+=wk*__uint_as_float(pv[e]<<16); x[2*e+1]+=wk*__uint_as_float(pv[e]&0xffff0000u); } } }
      const u32x4 g=gvv[i]; u32x4 v;
      #pragma unroll
      for(int e=0;e<4;++e){ const float g0=__uint_as_float(g[e]<<16),g1=__uint_as_float(g[e]&0xffff0000u);
        v[e]=cvtpk_s(x[2*e]*g0*__builtin_amdgcn_rcpf(1.f+__builtin_amdgcn_exp2f(-1.4426950408889634f*g0)),x[2*e+1]*g1*__builtin_amdgcn_rcpf(1.f+__builtin_amdgcn_exp2f(-1.4426950408889634f*g1))); }
      ATTN_STORE16(Ow+(long)row*DMO+ch*8,v); }
  }
  ATS_E(53);
  }
  asm volatile("s_waitcnt lgkmcnt(0)\n\ts_barrier":::"memory");
  #undef DMA_K
  #undef DMA_V
  #undef CMASK
  #undef CINIT
  #undef START
  #undef RESC
  #undef ROT
}
constexpr int ATTN_LDS_BYTES=LDS_BYTES;
#undef SBAR
#undef WAIT_BAR
#undef LWAIT
}

#define GAS __attribute__((address_space(1)))
#define LAS __attribute__((address_space(3)))
typedef unsigned v4u __attribute__((ext_vector_type(4)));
typedef float f32x4 __attribute__((ext_vector_type(4)));
typedef GAS unsigned gu32;
#define RLX_AGENT __ATOMIC_RELAXED, __HIP_MEMORY_SCOPE_AGENT
#define LDS_WAIT() asm volatile("s_waitcnt lgkmcnt(0)" ::: "memory")
#define VM_WAIT() asm volatile("s_waitcnt vmcnt(0)" ::: "memory")
#define XB_TMO      128
#define XB_XCNT(j)  (256  + 64 * (j))
#define XB_XSUB(j)  (1280 + 64 * (j))
#define XB_XGEN(j)  (2304 + 64 * (j))
#define XB_TOP      3328
#define XB_TOPGEN   3392
#define XCD_BAR_WORDS 3456
#define XB_SPIN_CAP (1u << 18)

__device__ __forceinline__ unsigned xb_ld(unsigned* p)              { return __hip_atomic_load(p, __ATOMIC_RELAXED, __HIP_MEMORY_SCOPE_AGENT); }
__device__ __forceinline__ unsigned xb_add(unsigned* p, unsigned v) { return __hip_atomic_fetch_add(p, v, __ATOMIC_RELAXED, __HIP_MEMORY_SCOPE_AGENT); }
__device__ __forceinline__ unsigned xb_xcc_id() { return (unsigned)__builtin_amdgcn_s_getreg((3 << 11) | 20) & 0xFu; }
#define XB_SPIN(cond, bar) do { unsigned _sp = 0; while (cond) { __builtin_amdgcn_s_sleep(1); \
    if ((++_sp & 255u) == 0u) { if (xb_ld(&(bar)[XB_TMO])) break; if (_sp > XB_SPIN_CAP) { atomicAdd(&(bar)[XB_TMO], 1u); break; } } } } while (0)

struct XcdBarrier {
    unsigned* bar; unsigned x;
    volatile LAS unsigned* st;
};

__device__ __forceinline__ XcdBarrier xcd_barrier_post(unsigned* bar, volatile LAS unsigned* st) {
    XcdBarrier b; b.bar = bar; b.x = xb_xcc_id(); b.st = st;
    if (threadIdx.x == 0) (void)xb_add(&bar[XB_XCNT(b.x)], 1u);
    return b;
}
__device__ __forceinline__ void xcd_barrier_complete(unsigned* bar, unsigned x, unsigned& nloc, unsigned& nx) {
    const unsigned G = gridDim.x * gridDim.y * gridDim.z;
    unsigned sum, cnt, mine, sp = 0u;
    for (;;) {
        sum = 0u; cnt = 0u; mine = 0u;
#pragma unroll
        for (unsigned j = 0; j < 16; ++j) { const unsigned c = xb_ld(&bar[XB_XCNT(j)]); sum += c; cnt += (c > 0u) ? 1u : 0u; mine = (j == x) ? c : mine; }
        if (sum == G) break;
        __builtin_amdgcn_s_sleep(1);
        if ((++sp & 255u) == 0u) { if (xb_ld(&bar[XB_TMO])) break; if (sp > XB_SPIN_CAP) { atomicAdd(&bar[XB_TMO], 1u); break; } }
    }
    nloc = mine > 0u ? mine : 1u; nx = cnt > 0u ? cnt : 1u;
}

__device__ __forceinline__ void xcd_barrier(const XcdBarrier& b) {
    asm volatile("s_waitcnt vmcnt(0)" ::: "memory");
    __syncthreads();
    if (threadIdx.x == 0) {
        unsigned* bar = b.bar;
        __builtin_amdgcn_s_waitcnt(0);
        unsigned nloc = b.st[0], nx = b.st[1];
        if (nloc == 0u) { xcd_barrier_complete(bar, b.x, nloc, nx); b.st[0] = nloc; b.st[1] = nx; }
        const unsigned old = xb_add(&bar[XB_XSUB(b.x)], 1u);
        const unsigned gen = old / nloc;
        if (old + 1u == (gen + 1u) * nloc) {
            __builtin_amdgcn_fence(__ATOMIC_RELEASE, "agent");
            asm volatile("s_waitcnt vmcnt(0)" ::: "memory");
            const unsigned og = xb_add(&bar[XB_TOP], 1u);
            const unsigned tg = og / nx;
            if (og + 1u == (tg + 1u) * nx) xb_add(&bar[XB_TOPGEN], 1u);
            else XB_SPIN(xb_ld(&bar[XB_TOPGEN]) == tg, bar);
            __builtin_amdgcn_fence(__ATOMIC_ACQUIRE, "agent");
            xb_add(&bar[XB_XGEN(b.x)], 1u);
            asm volatile("s_waitcnt vmcnt(0)" ::: "memory");
        } else {
            XB_SPIN(xb_ld(&bar[XB_XGEN(b.x)]) == gen, bar);
            __builtin_amdgcn_fence(__ATOMIC_ACQUIRE, "agent");
            asm volatile("s_waitcnt vmcnt(0)" ::: "memory");
        }
    }
    __syncthreads();
}


constexpr int NWAVES = 8;
constexpr int RING_OFF = 0, RING_BYTES = 131072;
constexpr int LDSCTL_OFF = RING_BYTES, MISC_OFF = LDSCTL_OFF + 320;
constexpr int LDS_BYTES = 147456;
constexpr size_t MiB = 1u << 20;
constexpr size_t WS_CTL = 0, CTL_ZERO_BYTES = 1 * MiB;
constexpr size_t WS_WIN = 1 * MiB;
constexpr size_t WS_WOUT = 16 * MiB;
constexpr size_t WS_DT = 20 * MiB;
constexpr size_t WS_SEL = 22 * MiB;
constexpr size_t WS_KMEAN = 21 * MiB;
constexpr size_t WS_PROJ = 24 * MiB;
constexpr size_t WS_HB = 264 * MiB;
constexpr size_t WS_ST = 328 * MiB;
constexpr size_t WS_END = 512 * MiB;
constexpr int CW_BAR = 4096;
constexpr int CW_CNT = 32768;
constexpr size_t WS_LIST = 380 * MiB;
constexpr size_t WS_PO = 396 * MiB;
constexpr size_t WS_ML = 444 * MiB;
constexpr size_t WS_YCAT = 448 * MiB;

struct Args { const float* in[15]; float* out; unsigned char* ws; int ph_lo, ph_hi, li, pad; };

struct Frame {
    LAS unsigned char* lds;
    volatile LAS unsigned* MISC;
    int tid, lane, wave, vcu, G;
};

__device__ __forceinline__ void p0_transpose_item(const float* W, int ld, int c0, int k0, bf16_t* WT, int row0, LAS float* scr, int lane) {
#pragma unroll 8
    for (int i = 0; i < 32; ++i) { const int kk = 2 * i + (lane >> 5); scr[kk * 33 + (lane & 31)] = W[(size_t)(k0 + kk) * ld + c0 + (lane & 31)]; }
    LDS_WAIT(); asm volatile("" ::: "memory");
    const int c = lane & 7;
#pragma unroll
    for (int j = 0; j < 4; ++j) { const int n = (lane >> 3) + 8 * j; const LAS float* s = scr + (8 * c) * 33 + n;
        v4u o; o.x = pk2(s[0 * 33], s[1 * 33]); o.y = pk2(s[2 * 33], s[3 * 33]); o.z = pk2(s[4 * 33], s[5 * 33]); o.w = pk2(s[6 * 33], s[7 * 33]);
        *(GAS v4u*)(WT + (size_t)(row0 + n) * 1024 + k0 + 8 * c) = o; }
    LDS_WAIT(); asm volatile("" ::: "memory");
}

typedef short bf16x8 __attribute__((ext_vector_type(8)));
typedef float f32x16 __attribute__((ext_vector_type(16)));
#define MFMA32(a, b, c) __builtin_amdgcn_mfma_f32_32x32x16_bf16(a, b, c, 0, 0, 0)
constexpr int TS = 144, TILE = 64 * TS;
constexpr int MX_AUX = 12 * TILE;
constexpr int STG_LD = 260;
constexpr int NCH = L / 64;
constexpr float LOG2E = 1.4426950408889634f;
__device__ __forceinline__ int crow(int r, int hi) { return (r & 3) + 8 * (r >> 2) + 4 * hi; }
__device__ __forceinline__ bf16x8 ldfrag(LAS const unsigned char* tile, int row, int kb) { return *(LAS const bf16x8*)(tile + row * TS + kb); }
__device__ __forceinline__ float fexp2(float x) { return __builtin_amdgcn_exp2f(x); }

constexpr size_t ST_ELEMS = (size_t)NB * NCH * 4 * 4096;
constexpr size_t WS_ST_U = WS_ST;
constexpr size_t WS_ST_DEC = WS_ST + 3 * ST_ELEMS * 2;
constexpr size_t WS_ST_EREF = WS_ST_DEC + (size_t)3 * NB * NCH * 4 * 64 * 4;
constexpr size_t WS_ST_END = WS_ST_EREF + (size_t)3 * NB * NCH * 4 * 64 * 4;

#define UTSB() do { if (PROBE_T >= 42 && PROBE_T <= 49 && blockIdx.x == 0 && F.tid == 0) F.MISC[16] = (unsigned)__builtin_amdgcn_s_memrealtime(); } while (0)
#define UTSE(k) do { if (PROBE_T == (k) && blockIdx.x == 0 && F.tid == 0) F.MISC[17] += (unsigned)__builtin_amdgcn_s_memrealtime() - F.MISC[16]; } while (0)
struct MixP {
    const bf16_t* proj; const float* dtraw; bf16_t* ycat;
    bf16_t* U; float* dec; float* eref;
    const float *conv_w, *conv_b, *dt_bias, *a_log, *ssd_d, *ssd_nw, *lb_logits, *hgrn_nw;
    int layer;
};

__device__ __forceinline__ void ld16x2(const bf16_t* p, float (&a)[16], float (&b)[16]) {
    unsigned r[16];
#pragma unroll
    for (int i = 0; i < 16; ++i) r[i] = *(const unsigned*)(p + (size_t)i * PLD);
#pragma unroll
    for (int i = 0; i < 16; ++i) { a[i] = __uint_as_float(r[i] << 16); b[i] = __uint_as_float(r[i] & 0xffff0000u); }
}
__device__ __forceinline__ void ldraw16(const bf16_t* p, unsigned (&r)[16]) {
#pragma unroll
    for (int i = 0; i < 16; ++i) r[i] = *(const unsigned*)(p + (size_t)i * PLD);
}
__device__ __forceinline__ void unpk16(const unsigned (&r)[16], float (&a)[16], float (&b)[16]) {
#pragma unroll
    for (int i = 0; i < 16; ++i) { a[i] = __uint_as_float(r[i] << 16); b[i] = __uint_as_float(r[i] & 0xffff0000u); }
}
__device__ __forceinline__ void st_row16(LAS unsigned char* p, const float (&a)[16]) {
    v4u o0, o1;
    o0.x = pk2(a[0], a[1]); o0.y = pk2(a[2], a[3]); o0.z = pk2(a[4], a[5]); o0.w = pk2(a[6], a[7]);
    o1.x = pk2(a[8], a[9]); o1.y = pk2(a[10], a[11]); o1.z = pk2(a[12], a[13]); o1.w = pk2(a[14], a[15]);
    *(LAS v4u*)p = o0; *(LAS v4u*)(p + 16) = o1;
}

__device__ __forceinline__ void state_core(LAS const unsigned char* VT, LAS const unsigned char* KdT, bf16_t* Uout, int rh, int lane) {
    const int r32 = lane & 31, hi = lane >> 5;
    f32x16 u[2] = {};
#pragma unroll
    for (int ks = 0; ks < 4; ++ks) {
        const bf16x8 a = ldfrag(VT, 32 * rh + r32, 32 * ks + 16 * hi);
#pragma unroll
        for (int ct = 0; ct < 2; ++ct) { const bf16x8 b = ldfrag(KdT, 32 * ct + r32, 32 * ks + 16 * hi); u[ct] = MFMA32(a, b, u[ct]); }
    }
#pragma unroll
    for (int ct = 0; ct < 2; ++ct)
#pragma unroll
        for (int r = 0; r < 16; ++r) Uout[(32 * rh + crow(r, hi)) * 64 + 32 * ct + r32] = f2bf(u[ct][r]);
}

typedef short s16x4_t __attribute__((ext_vector_type(4)));
template <bool SCALE>
__device__ __forceinline__ void out_core(LAS unsigned char* lds, int hh, int rh, int lane, const bf16x8 (&sf)[2][4], float diag) {
    const int r32 = lane & 31, hi = lane >> 5;
    LAS unsigned char* Qp = lds + hh * 3 * TILE; LAS unsigned char* Kp = Qp + TILE; LAS unsigned char* VT = Qp + 2 * TILE;
    LAS const float* ra = (LAS const float*)(lds + MX_AUX) + hh * 64; LAS const float* cm = ra + 256;
    bf16x8 af[4];
#pragma unroll
    for (int ks = 0; ks < 4; ++ks) af[ks] = ldfrag(Qp, 32 * rh + r32, 32 * ks + 16 * hi);
    f32x16 o[2] = {};
#pragma unroll
    for (int ks = 0; ks < 4; ++ks) { o[0] = MFMA32(af[ks], sf[0][ks], o[0]); o[1] = MFMA32(af[ks], sf[1][ks], o[1]); }
    if (SCALE) {
#pragma unroll
        for (int g = 0; g < 4; ++g) { const f32x4 rv = *(LAS const f32x4*)(ra + 32 * rh + 8 * g + 4 * hi);
#pragma unroll
            for (int j = 0; j < 4; ++j) { const float e = fexp2(rv[j]); o[0][4 * g + j] *= e; o[1][4 * g + j] *= e; } }
    }
    const int t = 32 * rh + r32;
    const float rat = SCALE ? ra[t] : 0.f;
#pragma unroll
    for (int st = 0; st < 2; ++st) if (st == 0 || rh) {
        f32x16 x = {};
#pragma unroll
        for (int ks = 0; ks < 4; ++ks) x = MFMA32(ldfrag(Kp, 32 * st + r32, 32 * ks + 16 * hi), af[ks], x);
#pragma unroll
        for (int g = 0; g < 4; ++g) {
            f32x4 rs = (f32x4){0.f, 0.f, 0.f, 0.f}, cs = (f32x4){1.f, 1.f, 1.f, 1.f};
            if (SCALE) { rs = *(LAS const f32x4*)(ra + 32 * st + 8 * g + 4 * hi); cs = *(LAS const f32x4*)(cm + 32 * st + 8 * g + 4 * hi); }
#pragma unroll
            for (int j = 0; j < 4; ++j) {
                const int i = 4 * g + j, s = 32 * st + 8 * g + 4 * hi + j;
                float v = x[i];
                if (SCALE) v *= fexp2(fminf(rat - rs[j], 0.f)) * cs[j];
                if (s == t) v += diag;
                x[i] = (s <= t) ? v : 0.f;
            }
        }
#pragma unroll
        for (int s2 = 0; s2 < 2; ++s2) {
            v4u pk; pk.x = pk2(x[8 * s2 + 0], x[8 * s2 + 1]); pk.y = pk2(x[8 * s2 + 2], x[8 * s2 + 3]); pk.z = pk2(x[8 * s2 + 4], x[8 * s2 + 5]); pk.w = pk2(x[8 * s2 + 6], x[8 * s2 + 7]);
            const bf16x8 xa = __builtin_bit_cast(bf16x8, pk);
#pragma unroll
            for (int ct = 0; ct < 2; ++ct) {
                LAS const unsigned char* vp = VT + (32 * ct + r32) * TS + (32 * st + 16 * s2 + 4 * hi) * 2;
                const s16x4_t lo = *(LAS const s16x4_t*)vp, h4 = *(LAS const s16x4_t*)(vp + 16);
                const bf16x8 vb = __builtin_shufflevector(lo, h4, 0, 1, 2, 3, 4, 5, 6, 7);
                o[ct] = MFMA32(xa, vb, o[ct]);
            }
        }
    }
    __syncthreads();
    LAS float* stg = (LAS float*)lds;
#pragma unroll
    for (int ct = 0; ct < 2; ++ct)
#pragma unroll
        for (int r = 0; r < 16; ++r) stg[(32 * rh + crow(r, hi)) * STG_LD + hh * 64 + 32 * ct + r32] = o[ct][r];
    __syncthreads();
}

#ifndef PF_ENABLE
#define PF_ENABLE 0
#endif
__device__ __forceinline__ void pf_issue(const Frame& F, const bf16_t* proj, int nmx, int nb, int nc, int col0, int nlines, unsigned (&pf)[2]) {
    pf[0] = 0u; pf[1] = 0u;
    if (nmx < 0 || !PF_ENABLE) return;
    const int row = F.tid >> 3, seg = F.tid & 7;
    const bf16_t* p = proj + ((size_t)nb * L + 64 * nc + row) * PLD + col0;
    if (seg < nlines) pf[0] = *(const unsigned*)(p + 64 * seg);
    if (seg + 8 < nlines) pf[1] = *(const unsigned*)(p + 64 * (seg + 8));
}
__device__ __forceinline__ void pf_done(const unsigned (&pf)[2]) { asm volatile("" :: "v"(pf[0]), "v"(pf[1])); }
__device__ __forceinline__ int pf_col(int ph, int mx) { return ph ? (mx == 0 ? 0 : (mx == 1 ? 768 : 1792)) : (mx == 0 ? 256 : (mx == 1 ? 1024 : 2048)); }
__device__ __forceinline__ int pf_nl(int ph, int mx) { return ph ? (mx == 0 ? 12 : 16) : 8; }
__device__ __forceinline__ float hgrn_lb(const float* lb_logits, int layer, int ch) {
    if (layer == 0) return 0.f;
    const float l0 = lb_logits[ch], l1 = lb_logits[256 + ch]; const float mx = fmaxf(l0, l1); const float e0 = __expf(l0 - mx), e1 = __expf(l1 - mx); return e1 / (e0 + e1);
}
__device__ __forceinline__ void hgrn_gates(const Frame& F, const MixP& P, const unsigned (&rf)[16], int c0, int q4, int cp, float (&kA)[16], float (&kB)[16], float (&bA)[16], float (&bB)[16],
                                           float& brefA, float& brefB, float& blastA, float& blastB) {
    const float lbA = hgrn_lb(P.lb_logits, P.layer, c0), lbB = hgrn_lb(P.lb_logits, P.layer, c0 + 1);
    unpk16(rf, kA, kB);
    float ca = 0.f, cb = 0.f;
#pragma unroll
    for (int i = 0; i < 16; ++i) {
        const float fa = lbA + (1.f - lbA) * sigmoid_f(kA[i]), fb = lbB + (1.f - lbB) * sigmoid_f(kB[i]);
        kA[i] = 1.f - fa; kB[i] = 1.f - fb; ca += __builtin_amdgcn_logf(fa); cb += __builtin_amdgcn_logf(fb); bA[i] = ca; bB[i] = cb;
    }
    LAS float* tot = (LAS float*)(F.lds + MX_AUX + 2048) + (c0 >> 6) * 256 + (c0 & 63);
    *(LAS f32x2_cv*)(tot + q4 * 64) = (f32x2_cv){ca, cb};
    __syncthreads();
    const f32x2_cv t0 = *(LAS const f32x2_cv*)(tot), t1 = *(LAS const f32x2_cv*)(tot + 64), t2 = *(LAS const f32x2_cv*)(tot + 128), t3 = *(LAS const f32x2_cv*)(tot + 192);
    const float a0 = t0.x, a1 = t1.x, a2 = t2.x, a3 = t3.x, b0 = t0.y, b1 = t1.y, b2 = t2.y, b3 = t3.y;
    const float offA = (q4 > 0 ? a0 : 0.f) + (q4 > 1 ? a1 : 0.f) + (q4 > 2 ? a2 : 0.f), offB = (q4 > 0 ? b0 : 0.f) + (q4 > 1 ? b1 : 0.f) + (q4 > 2 ? b2 : 0.f);
#pragma unroll
    for (int i = 0; i < 16; ++i) { bA[i] += offA; bB[i] += offB; }
    brefA = a0 + a1; brefB = b0 + b1; blastA = brefA + a2 + a3; blastB = brefB + b2 + b3;
}

__device__ __forceinline__ void hgrn_state_unit(const Frame& F, const MixP& P, int b, int c, int nmx, int nb, int nc) {
    UTSB();
    int lane_l = F.lane; asm volatile("" : "+v"(lane_l));
    const int w = F.wave, lane = lane_l, q4 = 2 * (w & 1) + (lane >> 5), cp = lane & 31, c0 = 64 * (w >> 1) + 2 * cp, hh = w >> 1, rh = w & 1, d0 = c0 & 63;
    const int tok0 = b * L + 64 * c;
    LAS unsigned char* KdT = F.lds + hh * 3 * TILE; LAS unsigned char* VT = KdT + 2 * TILE;
    unsigned rf[16], ri[16];
    ldraw16(P.proj + (size_t)(tok0 + 16 * q4) * PLD + C_HF + c0, rf); ldraw16(P.proj + (size_t)(tok0 + 16 * q4) * PLD + C_HI + c0, ri);
    unsigned pf[2]; pf_issue(F, P.proj, nmx, nb, nc, pf_col(0, nmx), pf_nl(0, nmx), pf);
    if (PROBE_T == 48) { asm volatile("s_waitcnt vmcnt(0)" ::: "memory"); UTSE(48); UTSB(); }
    float kA[16], kB[16], bA[16], bB[16], brefA, brefB, blA, blB;
    hgrn_gates(F, P, rf, c0, q4, cp, kA, kB, bA, bB, brefA, brefB, blA, blB);
#pragma unroll
    for (int i = 0; i < 16; ++i) { kA[i] *= fexp2(blA - bA[i]); kB[i] *= fexp2(blB - bB[i]); }
    st_row16(KdT + d0 * TS + 32 * q4, kA); st_row16(KdT + (d0 + 1) * TS + 32 * q4, kB);
    unpk16(ri, kA, kB);
    st_row16(VT + d0 * TS + 32 * q4, kA); st_row16(VT + (d0 + 1) * TS + 32 * q4, kB);
    const size_t uidx = ((size_t)(b * NCH + c) * 4 + hh);
    if (q4 == 0) { *(float2*)(P.dec + uidx * 64 + d0) = make_float2(fexp2(blA), fexp2(blB)); *(float2*)(P.eref + uidx * 64 + d0) = make_float2(fexp2(brefA), fexp2(brefB)); }
    __syncthreads(); UTSE(46); UTSB();
    state_core(VT, KdT, P.U + uidx * 4096, rh, lane);
    pf_done(pf);
    __syncthreads(); UTSE(47);
}

__device__ __forceinline__ void hgrn_out_unit(const Frame& F, const MixP& P, int b, int c, int nmx, int nb, int nc) {
    UTSB();
    int lane_l = F.lane; asm volatile("" : "+v"(lane_l));
    const int w = F.wave, lane = lane_l, q4 = 2 * (w & 1) + (lane >> 5), cp = lane & 31, c0 = 64 * (w >> 1) + 2 * cp, hh = w >> 1, rh = w & 1, d0 = c0 & 63, r32 = lane & 31, hi = lane >> 5;
    const int tok0 = b * L + 64 * c;
    LAS unsigned char* Qp = F.lds + hh * 3 * TILE; LAS unsigned char* Kp = Qp + TILE; LAS unsigned char* VT = Qp + 2 * TILE;
    const size_t uidx = ((size_t)(b * NCH + c) * 4 + hh);
    bf16x8 sf[2][4];
    unsigned pf[2];
    uint2 gt[8];
    {
        unsigned rf[16], rq[16], ri[16];
        ldraw16(P.proj + (size_t)(tok0 + 16 * q4) * PLD + C_HF + c0, rf); ldraw16(P.proj + (size_t)(tok0 + 16 * q4) * PLD + C_HQ + c0, rq);
        ldraw16(P.proj + (size_t)(tok0 + 16 * q4) * PLD + C_HI + c0, ri);
        { const bf16_t* S = P.U + uidx * 4096;
    #pragma unroll
          for (int ct = 0; ct < 2; ++ct)
    #pragma unroll
              for (int ks = 0; ks < 4; ++ks) sf[ct][ks] = *(const bf16x8*)(S + (32 * ct + r32) * 64 + 16 * ks + 8 * hi); }
        { const bf16_t* gp = P.proj + (size_t)(tok0 + (F.tid >> 3)) * PLD + C_HG;
    #pragma unroll
          for (int j = 0; j < 8; ++j) gt[j] = *(const uint2*)(gp + 4 * ((F.tid & 7) + 8 * j)); }
        pf_issue(F, P.proj, nmx, nb, nc, pf_col(1, nmx), pf_nl(1, nmx), pf);
#pragma unroll
    for (int ct = 0; ct < 2; ++ct)
#pragma unroll
        for (int ks = 0; ks < 4; ++ks) asm volatile("" : "+v"(sf[ct][ks]));
#pragma unroll
    for (int j = 0; j < 8; ++j) asm volatile("" : "+v"(gt[j].x), "+v"(gt[j].y));
        float kA[16], kB[16], bA[16], bB[16], brefA, brefB, blA, blB;
        hgrn_gates(F, P, rf, c0, q4, cp, kA, kB, bA, bB, brefA, brefB, blA, blB);
        float qA[16], qB[16];
        unpk16(rq, qA, qB);
#pragma unroll
        for (int i = 0; i < 16; ++i) {
            const int t = 16 * q4 + i;
            const float ea = fexp2(fminf(bA[i] - brefA, 115.f)), eb = fexp2(fminf(bB[i] - brefB, 115.f));
            const float ka = kA[i] * fexp2(fminf(brefA - bA[i], 115.f)), kb = kB[i] * fexp2(fminf(brefB - bB[i], 115.f));
            *(LAS unsigned*)(Qp + t * TS + d0 * 2) = pk2(qA[i] * ea, qB[i] * eb);
            *(LAS unsigned*)(Kp + t * TS + d0 * 2) = pk2(ka, kb);
        }
        unpk16(ri, qA, qB);
        st_row16(VT + d0 * TS + 32 * q4, qA); st_row16(VT + (d0 + 1) * TS + 32 * q4, qB);
    }
    __syncthreads(); UTSE(42); UTSB();
    out_core<false>(F.lds, hh, rh, lane, sf, 0.f); UTSE(43); UTSB();
    {
        const int row = F.tid >> 3, seg = F.tid & 7;
        LAS const float* stg = (LAS const float*)F.lds + row * STG_LD;
        bf16_t* yp = P.ycat + (size_t)(tok0 + row) * D + 256;
        f32x4 v[8], nwv[8]; float ss[4] = {0.f, 0.f, 0.f, 0.f};
#pragma unroll
        for (int j = 0; j < 8; ++j) nwv[j] = *(const f32x4*)(P.hgrn_nw + 4 * (seg + 8 * j));
#pragma unroll
        for (int j = 0; j < 8; ++j) { v[j] = *(LAS const f32x4*)(stg + 4 * (seg + 8 * j)); ss[j >> 1] += v[j].x * v[j].x + v[j].y * v[j].y + v[j].z * v[j].z + v[j].w * v[j].w; }
#pragma unroll
        for (int k = 0; k < 4; ++k) { ss[k] += __shfl_xor(ss[k], 1); ss[k] += __shfl_xor(ss[k], 2); ss[k] += __shfl_xor(ss[k], 4); ss[k] = rsqrtf(ss[k] * (1.f / 64.f) + RMS_EPS); }
#pragma unroll
        for (int j = 0; j < 8; ++j) {
            const int ch = 4 * (seg + 8 * j);
            const uint2 g2 = gt[j]; const f32x4 nw = nwv[j];
            const float g0 = __uint_as_float(g2.x << 16), g1 = __uint_as_float(g2.x & 0xffff0000u), g2f = __uint_as_float(g2.y << 16), g3 = __uint_as_float(g2.y & 0xffff0000u);
            const float r = ss[j >> 1];
            uint2 o; o.x = pk2(v[j].x * r * nw.x * silu_f(g0), v[j].y * r * nw.y * silu_f(g1)); o.y = pk2(v[j].z * r * nw.z * silu_f(g2f), v[j].w * r * nw.w * silu_f(g3));
            *(uint2*)(yp + ch) = o;
        }
    }
    pf_done(pf);
    __syncthreads(); UTSE(44);
}

__device__ __forceinline__ float ret_lg(int h);
template <int MX>
__device__ __forceinline__ void scan_chain(bf16_t* U, const float* dec, const float* er, float cdec) {
    float s0 = 0.f, s1 = 0.f;
    for (int cb = 0; cb < NCH; cb += 16) {
        unsigned uu[16]; float2 dc[16], ee[16];
#pragma unroll
        for (int k = 0; k < 16; ++k) {
            uu[k] = *(const unsigned*)(U + (size_t)(cb + k) * 4 * 4096);
            if (MX == 1) { dc[k] = *(const float2*)(dec + (size_t)(cb + k) * 4 * 64); ee[k] = *(const float2*)(er + (size_t)(cb + k) * 4 * 64); }
            else if (MX == 0) { const float x = dec[(size_t)(cb + k) * 4 * 64]; dc[k] = make_float2(x, x); ee[k] = make_float2(1.f, 1.f); }
            else { dc[k] = make_float2(cdec, cdec); ee[k] = make_float2(1.f, 1.f); }
        }
#pragma unroll
        for (int k = 0; k < 16; ++k) { asm volatile("" : "+v"(uu[k])); if (MX != 2) { asm volatile("" : "+v"(dc[k].x), "+v"(dc[k].y)); } if (MX == 1) { asm volatile("" : "+v"(ee[k].x), "+v"(ee[k].y)); } }
#pragma unroll
        for (int k = 0; k < 16; ++k) {
            *(unsigned*)(U + (size_t)(cb + k) * 4 * 4096) = pk2(s0 * ee[k].x, s1 * ee[k].y);
            s0 = dc[k].x * s0 + __uint_as_float(uu[k] << 16); s1 = dc[k].y * s1 + __uint_as_float(uu[k] & 0xffff0000u);
        }
    }
}
__device__ __forceinline__ void scan_phase(const Frame& F, bf16_t* Uall, const float* decall, const float* erefall, int mx_lo, int mx_hi, size_t wofs) {
    if (F.wave >= 6) return;
    const int nthreads = F.G * 6 * 64;
    const int gt = (F.vcu * 6 + F.wave) * 64 + F.lane;
    const int per_mx = NB * 4 * 2048;
    for (int it = gt; it < (mx_hi - mx_lo) * per_mx; it += nthreads) {
        const int mx = mx_lo + it / per_mx; int r = it % per_mx;
        const int b = r / (4 * 2048); r %= (4 * 2048); const int h = r / 2048; const int e = r % 2048;
        const int d = (e & 31) * 2;
        bf16_t* U = Uall + (size_t)mx * ST_ELEMS + ((size_t)(b * NCH) * 4 + h) * 4096 + (size_t)e * 2;
        const float* dec = decall + ((size_t)mx * NB * NCH * 4 + (size_t)(b * NCH) * 4 + h) * 64 + d;
        const float* er = erefall + ((size_t)mx * NB * NCH * 4 + (size_t)(b * NCH) * 4 + h) * 64 + d;
        if (mx == 1) scan_chain<1>(U, dec, er, 0.f);
        else if (mx == 0) scan_chain<0>(U, dec, er, 0.f);
        else scan_chain<2>(U, dec, er, fexp2(ret_lg(h) * 64.f));
    }
}

__device__ __forceinline__ float ret_lg(int h) { return __log2f(1.f - exp2f(-5.f - (float)h)); }
__device__ __forceinline__ void ret_state_unit(const Frame& F, const MixP& P, int b, int c, int nmx, int nb, int nc) {
    UTSB();
    int lane_l = F.lane; asm volatile("" : "+v"(lane_l));
    const int w = F.wave, lane = lane_l, q4 = 2 * (w & 1) + (lane >> 5), cp = lane & 31, c0 = 64 * (w >> 1) + 2 * cp, hh = w >> 1, rh = w & 1, d0 = c0 & 63;
    const int tok0 = b * L + 64 * c;
    LAS unsigned char* KdT = F.lds + hh * 3 * TILE; LAS unsigned char* VT = KdT + 2 * TILE;
    const float lg = ret_lg(hh);
    unsigned rk[16], rv[16];
    ldraw16(P.proj + (size_t)(tok0 + 16 * q4) * PLD + C_RK + c0, rk); ldraw16(P.proj + (size_t)(tok0 + 16 * q4) * PLD + C_RV + c0, rv);
    unsigned pf[2]; pf_issue(F, P.proj, nmx, nb, nc, pf_col(0, nmx), pf_nl(0, nmx), pf);
    if (PROBE_T == 48) { asm volatile("s_waitcnt vmcnt(0)" ::: "memory"); UTSE(48); UTSB(); }
    float kA[16], kB[16];
    unpk16(rk, kA, kB);
#pragma unroll
    for (int i = 0; i < 16; ++i) { const float e = 0.125f * fexp2(lg * (float)(63 - 16 * q4 - i)); kA[i] *= e; kB[i] *= e; }
    st_row16(KdT + d0 * TS + 32 * q4, kA); st_row16(KdT + (d0 + 1) * TS + 32 * q4, kB);
    unpk16(rv, kA, kB);
    st_row16(VT + d0 * TS + 32 * q4, kA); st_row16(VT + (d0 + 1) * TS + 32 * q4, kB);
    const size_t uidx = ((size_t)(b * NCH + c) * 4 + hh);
    if (rh == 0) { P.dec[uidx * 64 + lane] = fexp2(lg * 64.f); P.eref[uidx * 64 + lane] = 1.f; }
    __syncthreads(); UTSE(46); UTSB();
    state_core(VT, KdT, P.U + uidx * 4096, rh, lane);
    pf_done(pf);
    __syncthreads(); UTSE(47);
}
__device__ __forceinline__ void ret_out_unit(const Frame& F, const MixP& P, int b, int c, int nmx, int nb, int nc) {
    UTSB();
    int lane_l = F.lane; asm volatile("" : "+v"(lane_l));
    const int w = F.wave, lane = lane_l, q4 = 2 * (w & 1) + (lane >> 5), cp = lane & 31, c0 = 64 * (w >> 1) + 2 * cp, hh = w >> 1, rh = w & 1, d0 = c0 & 63, r32 = lane & 31, hi = lane >> 5;
    const int tok0 = b * L + 64 * c;
    LAS unsigned char* Qp = F.lds + hh * 3 * TILE; LAS unsigned char* Kp = Qp + TILE; LAS unsigned char* VT = Qp + 2 * TILE;
    LAS float* ra = (LAS float*)(F.lds + MX_AUX) + hh * 64; LAS float* cm = ra + 256;
    const size_t uidx = ((size_t)(b * NCH + c) * 4 + hh);
    bf16x8 sf[2][4];
    unsigned pf[2];
    uint2 gt[8];
    {
        unsigned rq[16], rk[16], rv[16];
        ldraw16(P.proj + (size_t)(tok0 + 16 * q4) * PLD + C_RQ + c0, rq); ldraw16(P.proj + (size_t)(tok0 + 16 * q4) * PLD + C_RK + c0, rk);
        ldraw16(P.proj + (size_t)(tok0 + 16 * q4) * PLD + C_RV + c0, rv);
        { const bf16_t* S = P.U + uidx * 4096;
    #pragma unroll
          for (int ct = 0; ct < 2; ++ct)
    #pragma unroll
              for (int ks = 0; ks < 4; ++ks) sf[ct][ks] = *(const bf16x8*)(S + (32 * ct + r32) * 64 + 16 * ks + 8 * hi); }
        { const bf16_t* gp = P.proj + (size_t)(tok0 + (F.tid >> 3)) * PLD + C_RG;
    #pragma unroll
          for (int j = 0; j < 8; ++j) gt[j] = *(const uint2*)(gp + 4 * ((F.tid & 7) + 8 * j)); }
        pf_issue(F, P.proj, nmx, nb, nc, pf_col(1, nmx), pf_nl(1, nmx), pf);
#pragma unroll
    for (int ct = 0; ct < 2; ++ct)
#pragma unroll
        for (int ks = 0; ks < 4; ++ks) asm volatile("" : "+v"(sf[ct][ks]));
#pragma unroll
    for (int j = 0; j < 8; ++j) asm volatile("" : "+v"(gt[j].x), "+v"(gt[j].y));
        float qA[16], qB[16];
#pragma unroll
        for (int i = 0; i < 16; ++i) *(LAS unsigned*)(Qp + (16 * q4 + i) * TS + d0 * 2) = rq[i];
        unpk16(rk, qA, qB);
#pragma unroll
        for (int i = 0; i < 16; ++i) *(LAS unsigned*)(Kp + (16 * q4 + i) * TS + d0 * 2) = pk2(qA[i] * 0.125f, qB[i] * 0.125f);
        unpk16(rv, qA, qB);
        st_row16(VT + d0 * TS + 32 * q4, qA); st_row16(VT + (d0 + 1) * TS + 32 * q4, qB);
        if (rh == 0) { ra[lane] = ret_lg(hh) * (float)(lane + 1); cm[lane] = 1.f; }
    }
    __syncthreads(); UTSE(42); UTSB();
    out_core<true>(F.lds, hh, rh, lane, sf, 0.f); UTSE(43); UTSB();
    {
        const int row = F.tid >> 3, seg = F.tid & 7;
        LAS const float* stg = (LAS const float*)F.lds + row * STG_LD;
        bf16_t* yp = P.ycat + (size_t)(tok0 + row) * D + 512;
        f32x4 v[8]; float mu[4] = {0.f, 0.f, 0.f, 0.f}, ss[4] = {0.f, 0.f, 0.f, 0.f};
#pragma unroll
        for (int j = 0; j < 8; ++j) { v[j] = *(LAS const f32x4*)(stg + 4 * (seg + 8 * j)); mu[j >> 1] += (v[j].x + v[j].y) + (v[j].z + v[j].w); }
#pragma unroll
        for (int k = 0; k < 4; ++k) { mu[k] += __shfl_xor(mu[k], 1); mu[k] += __shfl_xor(mu[k], 2); mu[k] += __shfl_xor(mu[k], 4); mu[k] *= (1.f / 64.f); }
#pragma unroll
        for (int j = 0; j < 8; ++j) { v[j] = v[j] - mu[j >> 1]; ss[j >> 1] += v[j].x * v[j].x + v[j].y * v[j].y + v[j].z * v[j].z + v[j].w * v[j].w; }
#pragma unroll
        for (int k = 0; k < 4; ++k) { ss[k] += __shfl_xor(ss[k], 1); ss[k] += __shfl_xor(ss[k], 2); ss[k] += __shfl_xor(ss[k], 4); ss[k] = rsqrtf(ss[k] * (1.f / 64.f) + LN_EPS); }
#pragma unroll
        for (int j = 0; j < 8; ++j) {
            const int ch = 4 * (seg + 8 * j);
            const uint2 g2 = gt[j];
            const float g0 = __uint_as_float(g2.x << 16), g1 = __uint_as_float(g2.x & 0xffff0000u), g2f = __uint_as_float(g2.y << 16), g3 = __uint_as_float(g2.y & 0xffff0000u);
            const float r = ss[j >> 1];
            uint2 o; o.x = pk2(v[j].x * r * silu_f(g0), v[j].y * r * silu_f(g1)); o.y = pk2(v[j].z * r * silu_f(g2f), v[j].w * r * silu_f(g3));
            *(uint2*)(yp + ch) = o;
        }
    }
    pf_done(pf);
    __syncthreads(); UTSE(44);
}

__device__ __forceinline__ void ssd_conv_ld(const MixP& P, int tok0, bool first_chunk, int q4, int xch, unsigned (&r)[19]) {
    const bf16_t* p = P.proj + (size_t)(tok0 + 16 * q4) * PLD + C_XBC + xch;
#pragma unroll
    for (int i = 0; i < 19; ++i) r[i] = (first_chunk && q4 == 0 && i < 3) ? 0u : *(const unsigned*)(p + (ptrdiff_t)(i - 3) * PLD);
}
__device__ __forceinline__ void ssd_conv(const MixP& P, const unsigned (&r)[19], int xch, float (&aA)[16], float (&aB)[16]) {
    float wA[4], wB[4];
#pragma unroll
    for (int j = 0; j < 4; ++j) { wA[j] = P.conv_w[j * 512 + xch]; wB[j] = P.conv_w[j * 512 + xch + 1]; }
    const float cbA = P.conv_b[xch], cbB = P.conv_b[xch + 1];
#pragma unroll
    for (int i = 0; i < 16; ++i) {
        float sa = cbA, sb = cbB;
#pragma unroll
        for (int j = 0; j < 4; ++j) { sa += wA[j] * __uint_as_float(r[i + j] << 16); sb += wB[j] * __uint_as_float(r[i + j] & 0xffff0000u); }
        aA[i] = silu_f(sa); aB[i] = silu_f(sb);
    }
}
__device__ __forceinline__ void ssd_dt(const MixP& P, int tok0, int hh, int lane, float& dt, float& acum, float& alast) {
    const float r = P.dtraw[(size_t)(tok0 + lane) * 4 + hh] + P.dt_bias[hh];
    dt = r > 20.f ? r : log1pf(__expf(r));
    float a = dt * (-__expf(P.a_log[hh]));
#pragma unroll
    for (int o = 1; o < 64; o <<= 1) { const float n = __shfl_up(a, o); if (lane >= o) a += n; }
    acum = a; alast = __shfl(a, 63);
}
__device__ __forceinline__ void ssd_state_unit(const Frame& F, const MixP& P, int b, int c, int nmx, int nb, int nc) {
    UTSB();
    int lane_l = F.lane; asm volatile("" : "+v"(lane_l));
    const int w = F.wave, lane = lane_l, q4 = 2 * (w & 1) + (lane >> 5), cp = lane & 31, c0 = 64 * (w >> 1) + 2 * cp, hh = w >> 1, rh = w & 1, d0 = c0 & 63;
    const int tok0 = b * L + 64 * c;
    LAS float* wv = (LAS float*)(F.lds + MX_AUX);
    const size_t uidx = ((size_t)(b * NCH + c) * 4 + hh);
    unsigned rx[19], rb[19];
    ssd_conv_ld(P, tok0, c == 0, q4, c0, rx);
    if (w < 4) ssd_conv_ld(P, tok0, c == 0, q4, 256 + c0, rb);
    unsigned pf[2]; pf_issue(F, P.proj, nmx, nb, nc, pf_col(0, nmx), pf_nl(0, nmx), pf);
    if (PROBE_T == 48) { asm volatile("s_waitcnt vmcnt(0)" ::: "memory"); UTSE(48); UTSB(); }
    { float dt, acum, alast; ssd_dt(P, tok0, hh, lane, dt, acum, alast);
      if (rh == 0) { wv[hh * 64 + lane] = dt * __expf(alast - acum); P.dec[uidx * 64 + lane] = __expf(alast); P.eref[uidx * 64 + lane] = 1.f; } }
    float aA[16], aB[16];
    ssd_conv(P, rx, c0, aA, aB);
    { LAS unsigned char* VT = F.lds + hh * 3 * TILE + 2 * TILE; st_row16(VT + d0 * TS + 32 * q4, aA); st_row16(VT + (d0 + 1) * TS + 32 * q4, aB); }
    __syncthreads();
    if (w < 4) {
        ssd_conv(P, rb, 256 + c0, aA, aB);
        const int g = w >> 1;
#pragma unroll
        for (int hx = 0; hx < 2; ++hx) {
            const int h2 = 2 * g + hx; LAS unsigned char* KdT = F.lds + h2 * 3 * TILE;
            float tA[16], tB[16];
#pragma unroll
            for (int i = 0; i < 16; ++i) { const float ww = wv[h2 * 64 + 16 * q4 + i]; tA[i] = aA[i] * ww; tB[i] = aB[i] * ww; }
            st_row16(KdT + d0 * TS + 32 * q4, tA); st_row16(KdT + (d0 + 1) * TS + 32 * q4, tB);
        }
    }
    __syncthreads(); UTSE(46); UTSB();
    state_core(F.lds + hh * 3 * TILE + 2 * TILE, F.lds + hh * 3 * TILE, P.U + uidx * 4096, rh, lane);
    pf_done(pf);
    __syncthreads(); UTSE(47);
}
__device__ __forceinline__ void ssd_out_unit(const Frame& F, const MixP& P, int b, int c, int nmx, int nb, int nc) {
    UTSB();
    int lane_l = F.lane; asm volatile("" : "+v"(lane_l));
    const int w = F.wave, lane = lane_l, q4 = 2 * (w & 1) + (lane >> 5), cp = lane & 31, c0 = 64 * (w >> 1) + 2 * cp, hh = w >> 1, rh = w & 1, d0 = c0 & 63, r32 = lane & 31, hi = lane >> 5;
    const int tok0 = b * L + 64 * c;
    LAS float* ra = (LAS float*)(F.lds + MX_AUX) + hh * 64; LAS float* cm = ra + 256;
    const size_t uidx = ((size_t)(b * NCH + c) * 4 + hh);
    bf16x8 sf[2][4];
    uint2 gt[8];
    unsigned rx[19], rb[19];
    ssd_conv_ld(P, tok0, c == 0, q4, c0, rx); ssd_conv_ld(P, tok0, c == 0, q4, 256 + c0, rb);
    { const bf16_t* S = P.U + uidx * 4096;
#pragma unroll
      for (int ct = 0; ct < 2; ++ct)
#pragma unroll
          for (int ks = 0; ks < 4; ++ks) sf[ct][ks] = *(const bf16x8*)(S + (32 * ct + r32) * 64 + 16 * ks + 8 * hi); }
    { const bf16_t* zp = P.proj + (size_t)(tok0 + (F.tid >> 3)) * PLD + C_SZ;
#pragma unroll
      for (int j = 0; j < 8; ++j) gt[j] = *(const uint2*)(zp + 4 * ((F.tid & 7) + 8 * j)); }
    unsigned pf[2]; pf_issue(F, P.proj, nmx, nb, nc, pf_col(1, nmx), pf_nl(1, nmx), pf);
#pragma unroll
    for (int ct = 0; ct < 2; ++ct)
#pragma unroll
        for (int ks = 0; ks < 4; ++ks) asm volatile("" : "+v"(sf[ct][ks]));
#pragma unroll
    for (int j = 0; j < 8; ++j) asm volatile("" : "+v"(gt[j].x), "+v"(gt[j].y));
    { float dt, acum, alast; ssd_dt(P, tok0, hh, lane, dt, acum, alast); if (rh == 0) { ra[lane] = acum * LOG2E; cm[lane] = dt; } }
    {
        float aA[16], aB[16];
        ssd_conv(P, rx, c0, aA, aB);
        LAS unsigned char* VT = F.lds + hh * 3 * TILE + 2 * TILE; st_row16(VT + d0 * TS + 32 * q4, aA); st_row16(VT + (d0 + 1) * TS + 32 * q4, aB);
        ssd_conv(P, rb, 256 + c0, aA, aB);
        const int g = (w & 3) >> 1; const int slot = (w < 4) ? TILE : 0;
#pragma unroll
        for (int hx = 0; hx < 2; ++hx) { LAS unsigned char* T = F.lds + (2 * g + hx) * 3 * TILE + slot;
#pragma unroll
            for (int i = 0; i < 16; ++i) *(LAS unsigned*)(T + (16 * q4 + i) * TS + d0 * 2) = pk2(aA[i], aB[i]); }
    }
    __syncthreads(); UTSE(42); UTSB();
    out_core<true>(F.lds, hh, rh, lane, sf, P.ssd_d[hh]); UTSE(43); UTSB();
    {
        const int row = F.tid >> 3, seg = F.tid & 7;
        LAS const float* stg = (LAS const float*)F.lds + row * STG_LD;
        bf16_t* yp = P.ycat + (size_t)(tok0 + row) * D;
        f32x4 v[8], nwv[8]; float ss[2] = {0.f, 0.f};
#pragma unroll
        for (int j = 0; j < 8; ++j) nwv[j] = *(const f32x4*)(P.ssd_nw + 4 * (seg + 8 * j));
#pragma unroll
        for (int j = 0; j < 8; ++j) {
            const int ch = 4 * (seg + 8 * j);
            v[j] = *(LAS const f32x4*)(stg + ch);
            const uint2 z2 = gt[j];
            v[j].x *= silu_f(__uint_as_float(z2.x << 16)); v[j].y *= silu_f(__uint_as_float(z2.x & 0xffff0000u));
            v[j].z *= silu_f(__uint_as_float(z2.y << 16)); v[j].w *= silu_f(__uint_as_float(z2.y & 0xffff0000u));
            ss[j >> 2] += v[j].x * v[j].x + v[j].y * v[j].y + v[j].z * v[j].z + v[j].w * v[j].w;
        }
#pragma unroll
        for (int k = 0; k < 2; ++k) { ss[k] += __shfl_xor(ss[k], 1); ss[k] += __shfl_xor(ss[k], 2); ss[k] += __shfl_xor(ss[k], 4); ss[k] = rsqrtf(ss[k] * (1.f / 128.f) + RMS_EPS); }
#pragma unroll
        for (int j = 0; j < 8; ++j) {
            const int ch = 4 * (seg + 8 * j);
            const f32x4 nw = nwv[j]; const float r = ss[j >> 2];
            uint2 o; o.x = pk2(v[j].x * r * nw.x, v[j].y * r * nw.y); o.y = pk2(v[j].z * r * nw.z, v[j].w * r * nw.w);
            *(uint2*)(yp + ch) = o;
        }
    }
    pf_done(pf);
    __syncthreads(); UTSE(44);
}

__device__ __forceinline__ void moba_kmean_unit(const Frame& F, const bf16_t* proj, float* kmean, int b, int n, int chh) {
    const int ch = chh * 128 + (F.tid & 127), q = F.tid >> 7;
    const bf16_t* p = proj + ((size_t)b * L + n * 256 + q * 64) * PLD + C_MK + ch;
    float s = 0.f;
#pragma unroll 16
    for (int j = 0; j < 64; ++j) s += bf2f(p[(size_t)j * PLD]);
    LAS float* sh = (LAS float*)F.lds;
    if (q) sh[(q - 1) * 128 + (F.tid & 127)] = s;
    __syncthreads();
    if (!q) { s += sh[F.tid & 127] + sh[128 + (F.tid & 127)] + sh[256 + (F.tid & 127)]; kmean[(((size_t)(b * 4 + (ch >> 6))) * 32 + n) * 64 + (ch & 63)] = s * (1.f / 256.f); }
    __syncthreads();
}
__device__ __forceinline__ void moba_topk_unit(const Frame& F, const bf16_t* proj, const float* kmean, unsigned* sel, unsigned* cnt, unsigned* lists, int b, int j, int pass, int task) {
    const int lane = F.lane, r32 = lane & 31, hi = lane >> 5, h = task >> 1;
    bf16x8 ah[4], al[4];
    { const float* kr = kmean + ((size_t)((b * 4 + h) * 32 + r32)) * 64 + 8 * hi;
      f32x4 kx[4][2];
#pragma unroll
      for (int ks = 0; ks < 4; ++ks) { kx[ks][0] = *(const f32x4*)(kr + 16 * ks); kx[ks][1] = *(const f32x4*)(kr + 16 * ks + 4); }
#pragma unroll
      for (int ks = 0; ks < 4; ++ks) { asm volatile("" : "+v"(kx[ks][0]), "+v"(kx[ks][1])); }
#pragma unroll
      for (int ks = 0; ks < 4; ++ks) {
          const f32x4 x0 = kx[ks][0], x1 = kx[ks][1];
          const float xs[8] = {x0.x, x0.y, x0.z, x0.w, x1.x, x1.y, x1.z, x1.w};
#pragma unroll
          for (int e = 0; e < 8; ++e) { const bf16_t hb_ = f2bf(xs[e]); ah[ks][e] = (short)hb_; al[ks][e] = (short)f2bf(xs[e] - bf2f(hb_)); }
      } }
#pragma unroll 1
    for (int st = 0; st < 2; ++st) {
        const int t = j * 256 + pass * 128 + 64 * (task & 1) + 32 * st + r32;
        const bf16_t* qp = proj + ((size_t)b * L + t) * PLD + C_MQ + h * 64 + 8 * hi;
        f32x16 c = {};
#pragma unroll
        for (int ks = 0; ks < 4; ++ks) { const bf16x8 q = *(const bf16x8*)(qp + 16 * ks); c = MFMA32(ah[ks], q, c); c = MFMA32(al[ks], q, c); }
        float sc[32];
#pragma unroll
        for (int r = 0; r < 16; ++r) {
            const unsigned x = __float_as_uint(c[r]);
            auto rr = __builtin_amdgcn_permlane32_swap(x, x, false, false);
            const int n0 = (r & 3) + 8 * (r >> 2);
            sc[n0] = (n0 < j) ? __uint_as_float(rr[0]) : -INFINITY;
            sc[n0 + 4] = (n0 + 4 < j) ? __uint_as_float(rr[1]) : -INFINITY;
        }
        unsigned m = 0u; int bis[3]; bool haves[3];
#pragma unroll
        for (int r = 0; r < 3; ++r) {
            float best = -INFINITY; int bi = 0;
#pragma unroll
            for (int n = 0; n < 32; ++n) if (sc[n] > best) { best = sc[n]; bi = n; }
            bis[r] = bi; haves[r] = (best > -INFINITY) && hi == 0;
            if (best > -INFINITY) {
                m |= 1u << bi;
#pragma unroll
                for (int n = 0; n < 32; ++n) if (n == bi) sc[n] = -INFINITY;
            }
        }
        unsigned long long grp[3]; unsigned base[3];
#pragma unroll
        for (int r = 0; r < 3; ++r) {
            unsigned long long g = 0ull;
#pragma unroll
            for (int n = 0; n < 32; ++n) { const unsigned long long mk = __ballot(haves[r] && bis[r] == n); if (bis[r] == n) g = mk; }
            grp[r] = g; base[r] = 0u;
            if (haves[r] && lane == __ffsll((long long)g) - 1) base[r] = atomicAdd(cnt + 64 * ((b * 4 + h) * 32 + bis[r]), (unsigned)__popcll(g));
        }
#pragma unroll
        for (int r = 0; r < 3; ++r) {
            const int leader = haves[r] ? (__ffsll((long long)grp[r]) - 1) : lane;
            const unsigned bs = __shfl(base[r], leader);
            if (haves[r]) lists[(size_t)((b * 4 + h) * 32 + bis[r]) * 8192 + bs + (unsigned)__popcll(grp[r] & ((1ull << lane) - 1ull))] = (unsigned)t | ((unsigned)r << 13);
        }
        if (hi == 0) sel[((size_t)(b * 4 + h)) * L + t] = m;
    }
}

__device__ __forceinline__ int moba_build_prefix(const Frame& F, const unsigned* cnt, LAS int* pre) {
    if (F.wave == 0) {
        int nt[8]; int s = 0;
#pragma unroll
        for (int j = 0; j < 8; ++j) { const int e = 8 * F.lane + j; const int Lq = (e & 15) * 32 + (e >> 4); nt[j] = (int)((cnt[64 * Lq] + 511u) >> 9); s += nt[j]; }
        int inc = s;
#pragma unroll
        for (int o = 1; o < 64; o <<= 1) { const int n = __shfl_up(inc, o); if (F.lane >= o) inc += n; }
        int ex = inc - s;
#pragma unroll
        for (int j = 0; j < 8; ++j) { pre[8 * F.lane + j] = ex; ex += nt[j]; }
        if (F.lane == 63) pre[512] = ex;
    }
    __syncthreads();
    return pre[512];
}


__device__ __forceinline__ float dpp_add(float v, const int ctrl_sel) { return v; }
__device__ __forceinline__ float wave_sum_dpp(float v) {
    v += __builtin_bit_cast(float, __builtin_amdgcn_update_dpp(0, __builtin_bit_cast(int, v), 0xB1, 0xF, 0xF, true));
    v += __builtin_bit_cast(float, __builtin_amdgcn_update_dpp(0, __builtin_bit_cast(int, v), 0x4E, 0xF, 0xF, true));
    v += __builtin_bit_cast(float, __builtin_amdgcn_update_dpp(0, __builtin_bit_cast(int, v), 0x141, 0xF, 0xF, true));
    v += __builtin_bit_cast(float, __builtin_amdgcn_update_dpp(0, __builtin_bit_cast(int, v), 0x140, 0xF, 0xF, true));
    const int iv = __builtin_bit_cast(int, v);
    return (__builtin_bit_cast(float, __builtin_amdgcn_readlane(iv, 0)) + __builtin_bit_cast(float, __builtin_amdgcn_readlane(iv, 16)))
         + (__builtin_bit_cast(float, __builtin_amdgcn_readlane(iv, 32)) + __builtin_bit_cast(float, __builtin_amdgcn_readlane(iv, 48)));
}
template <bool SRC_BF16>
__device__ __forceinline__ void ln_phase(const Frame& F, const void* srcv, const float* g, const float* b, float* hout  , bf16_t* hb, const float* wdt  , float* dtraw) {
    const int lane = F.lane;
    const int gw = F.vcu * NWAVES + F.wave, NGW = F.G * NWAVES;
    f32x4 gg[4], bb[4];
#pragma unroll
    for (int j = 0; j < 4; ++j) { gg[j] = ((const f32x4*)g)[lane + 64 * j]; bb[j] = ((const f32x4*)b)[lane + 64 * j]; }
    f32x4 wd[4][4];
#pragma unroll
    for (int j = 0; j < 4; ++j)
#pragma unroll
        for (int i = 0; i < 4; ++i) wd[j][i] = hb ? *(const f32x4*)(wdt + (size_t)(4 * lane + 256 * j + i) * NIN) : (f32x4){0.f, 0.f, 0.f, 0.f};
#pragma unroll
    for (int j = 0; j < 4; ++j)
#pragma unroll
        for (int i = 0; i < 4; ++i) asm volatile("" : "+v"(wd[j][i]));
    f32x4 nx[4];
#define LN_LOAD(row_) do { if (SRC_BF16) { const uint2* xr = (const uint2*)((const bf16_t*)srcv + (size_t)(row_) * D) + lane; \
            _Pragma("unroll") for (int j = 0; j < 4; ++j) { const uint2 r = xr[64 * j]; nx[j] = (f32x4){__uint_as_float(r.x << 16), __uint_as_float(r.x & 0xffff0000u), __uint_as_float(r.y << 16), __uint_as_float(r.y & 0xffff0000u)}; } } \
        else { const f32x4* xr = (const f32x4*)((const float*)srcv + (size_t)(row_) * D) + lane; _Pragma("unroll") for (int j = 0; j < 4; ++j) nx[j] = xr[64 * j]; } } while (0)
    if (gw < M) LN_LOAD(gw);
    for (int row = gw; row < M; row += NGW) {
        f32x4 v[4];
#pragma unroll
        for (int j = 0; j < 4; ++j) v[j] = nx[j];
        if (row + NGW < M) LN_LOAD(row + NGW);
        float s = 0.f, s2 = 0.f;
#pragma unroll
        for (int j = 0; j < 4; ++j) { s += (v[j].x + v[j].y) + (v[j].z + v[j].w); s2 += (v[j].x * v[j].x + v[j].y * v[j].y) + (v[j].z * v[j].z + v[j].w * v[j].w); }
        s = wave_sum_dpp(s); s2 = wave_sum_dpp(s2);
        const float mean = s * (1.f / D);
        const float var = fmaxf(s2 * (1.f / D) - mean * mean, 0.f);
        const float rstd = rsqrtf(var + LN_EPS);
#pragma unroll
        for (int j = 0; j < 4; ++j) v[j] = (v[j] - mean) * rstd * gg[j] + bb[j];
        if (hout) { f32x4* o = (f32x4*)(hout + (size_t)row * D) + lane;
#pragma unroll
            for (int j = 0; j < 4; ++j) o[64 * j] = v[j]; }
        if (hb) {
            unsigned long long* o8 = (unsigned long long*)(hb + (size_t)row * D) + lane;
#pragma unroll
            for (int j = 0; j < 4; ++j) o8[64 * j] = (unsigned long long)pk2(v[j].x, v[j].y) | ((unsigned long long)pk2(v[j].z, v[j].w) << 32);
            f32x4 da = (f32x4){0.f, 0.f, 0.f, 0.f};
#pragma unroll
            for (int j = 0; j < 4; ++j) da += wd[j][0] * v[j].x + wd[j][1] * v[j].y + wd[j][2] * v[j].z + wd[j][3] * v[j].w;
            da.x = wave_sum_dpp(da.x); da.y = wave_sum_dpp(da.y); da.z = wave_sum_dpp(da.z); da.w = wave_sum_dpp(da.w);
            if (lane == 0) *(f32x4*)(dtraw + (size_t)row * 4) = da;
        }
    }
#undef LN_LOAD
}

template <int l>
__device__ __forceinline__ void layer_body(const Frame& F, const Args& args, const XcdBarrier& bar, int lo, int hi, char* ldsg) {
    unsigned char* ws = args.ws;
    const float* w_in = args.in[3];
    float* hres = args.out;
    bf16_t* WTin = (bf16_t*)(ws + WS_WIN);
    bf16_t* WTout = (bf16_t*)(ws + WS_WOUT);
    float* dtraw = (float*)(ws + WS_DT);
    bf16_t* proj = (bf16_t*)(ws + WS_PROJ);
    bf16_t* zbuf = (bf16_t*)(ws + WS_PROJ);
    const bf16_t* hbres = (const bf16_t*)(ws + WS_HB);
    bf16_t* hb = (bf16_t*)(ws + WS_HB);
    bf16_t* ycat = (bf16_t*)(ws + WS_YCAT);
    float* kmean = (float*)(ws + WS_KMEAN);
    unsigned* selm = (unsigned*)(ws + WS_SEL);
    unsigned* gcnt = (unsigned*)(ws + WS_CTL) + CW_CNT + 512 * 64 * l;
    unsigned* glist = (unsigned*)(ws + WS_LIST);
#define IN(k) (lo <= (k) && (k) < hi)
#define SEAM(k) do { if (IN(k) && IN((k) + 1)) xcd_barrier(bar); } while (0)
#define REP(k) ((l == 0 && PROBE_ID == (k)) ? 2 : 1)
#define TSB() do { if (PROBE_T && blockIdx.x == 0 && F.tid == 0) F.MISC[16] = (unsigned)__builtin_amdgcn_s_memrealtime(); } while (0)
#define TSE(k) do { if (PROBE_T == (k) && blockIdx.x == 0 && F.tid == 0) F.MISC[17] += (unsigned)__builtin_amdgcn_s_memrealtime() - F.MISC[16]; } while (0)
        const int pb = 1 + 7 * l;
        TSB();
        for (int rp = 0; rp < REP(1); ++rp) { if (rp) xcd_barrier(bar);
        if (IN(pb)) {
            pg8::Gemm g{hb, WTin + (size_t)l * PLD * D, M, PLD, D}; pg8::StaticOrder S; S.init(M, PLD, F.G, (int)blockIdx.x);
            pg8::EpiProj E{proj, QC2};
            pg8::gemm_phase<pg8::EpiProj, pg8::StaticOrder, true, true>(F.lds + RING_OFF, g, S, E);
        } }
        SEAM(pb); TSE(1); TSB();
        MixP P;
        P.proj = proj; P.dtraw = dtraw; P.ycat = ycat; P.U = (bf16_t*)(ws + WS_ST_U); P.dec = (float*)(ws + WS_ST_DEC); P.eref = (float*)(ws + WS_ST_EREF);
        P.conv_w = args.in[4] + l * 4 * 512; P.conv_b = args.in[5] + l * 512; P.dt_bias = args.in[6] + l * 4; P.a_log = args.in[7] + l * 4; P.ssd_d = args.in[8] + l * 4;
        P.ssd_nw = args.in[9] + l * 256; P.lb_logits = args.in[10]; P.hgrn_nw = args.in[11] + l * 256; P.layer = l;
        MixP Ph = P; Ph.U = P.U + ST_ELEMS; Ph.dec = P.dec + (size_t)NB * NCH * 4 * 64; Ph.eref = P.eref + (size_t)NB * NCH * 4 * 64;
        MixP Pr = P; Pr.U = P.U + 2 * ST_ELEMS; Pr.dec = P.dec + (size_t)2 * NB * NCH * 4 * 64; Pr.eref = P.eref + (size_t)2 * NB * NCH * 4 * 64;
        if (IN(pb + 1)) {
            for (int rp = 0; rp < REP(2); ++rp) {
            constexpr int NU = 3 * NB * NCH, UM = NB * NCH;
            for (int u = F.vcu; u < NU; u += F.G) { const int mx = u / UM, r = u % UM; const int un = u + F.G; const int nmx = un < NU ? un / UM : -1, nr = un % UM;
                if (mx == 0) ssd_state_unit(F, P, r / NCH, r % NCH, nmx, nr / NCH, nr % NCH); else if (mx == 1) hgrn_state_unit(F, Ph, r / NCH, r % NCH, nmx, nr / NCH, nr % NCH); else ret_state_unit(F, Pr, r / NCH, r % NCH, nmx, nr / NCH, nr % NCH); } }
            for (int rp = 0; rp < REP(3); ++rp)
            for (int u = F.vcu; u < NB * 64; u += F.G) moba_kmean_unit(F, proj, kmean, u >> 6, (u >> 1) & 31, u & 1);
        }
        SEAM(pb + 1); TSE(2); TSB();
        if (IN(pb + 2)) {
            volatile LAS unsigned* tick = F.MISC + 20;
            if (F.tid == 0) tick[0] = 0u;
            __syncthreads();
            scan_phase(F, P.U, P.dec, P.eref, 0, 3, 0); TSE(31);
            const int nun = (NB * 64 - F.vcu + F.G - 1) / F.G;
            for (;;) {
                unsigned tk = 0u;
                if (F.lane == 0) tk = __hip_atomic_fetch_add((LAS unsigned*)tick, 1u, __ATOMIC_RELAXED, __HIP_MEMORY_SCOPE_WORKGROUP);
                tk = (unsigned)__builtin_amdgcn_readfirstlane((int)tk);
                if ((int)tk >= 8 * nun) break;
                const int u = F.vcu + (int)(tk >> 3) * F.G;
                moba_topk_unit(F, proj, kmean, selm, gcnt, glist, u >> 6, (u >> 1) & 31, u & 1, (int)(tk & 7u));
            }
        }
        SEAM(pb + 2); TSE(3); TSB();
        if (IN(pb + 3)) {
            LAS int* pre = (LAS int*)(F.lds + 124928);
            LAS int* qs = pre + 520;
            unsigned* qctr = (unsigned*)(ws + WS_CTL) + CW_CNT + 2 * 512 * 64 + 64 * l;
            const int nitem = moba_build_prefix(F, gcnt, pre);
            const int quota0 = (nitem + F.G - 1) / F.G;
            const attn_body::AttnTensors AT{(const attn_body::bf16*)(proj + C_MQ), (const attn_body::bf16*)(proj + C_MK), (const attn_body::bf16*)(proj + C_MV), (const attn_body::bf16*)(proj + C_MG), (attn_body::bf16*)ycat, selm, (attn_body::bf16*)(ws + WS_PO), (float*)(ws + WS_ML)};
#pragma unroll 1
            for (int stage = 0; stage < 3; ++stage) {
                if (stage == 1) {
            for (int rp = 0; rp < REP(6); ++rp) {
            constexpr int NU = 3 * NB * NCH, UM = NB * NCH;
            for (int u = F.vcu; u < NU; u += F.G) { const int mx = u / UM, r = u % UM; const int un = u + F.G; const int nmx = un < NU ? un / UM : -1, nr = un % UM;
                if (mx == 0) ssd_out_unit(F, P, r / NCH, r % NCH, nmx, nr / NCH, nr % NCH); else if (mx == 1) hgrn_out_unit(F, Ph, r / NCH, r % NCH, nmx, nr / NCH, nr % NCH); else ret_out_unit(F, Pr, r / NCH, r % NCH, nmx, nr / NCH, nr % NCH); } }
                } else if (stage == 2 || (F.vcu & 1)) {
                    for (int taken = 0; stage == 2 || taken < quota0; ++taken) {
                        if (F.tid == 0) qs[0] = (int)atomicAdd(qctr, 1u);
                        __syncthreads();
                        const int g = qs[0];
                        __syncthreads();
                        if (g >= nitem) break;
                        int lo_ = 0, hi_ = 512;
                        while (hi_ - lo_ > 1) { const int mid = (lo_ + hi_) >> 1; if (pre[mid] <= g) lo_ = mid; else hi_ = mid; }
                        const int e = lo_, ci = g - pre[e], n = e >> 4, bh = e & 15, Lq = bh * 32 + n; const int nr = (int)gcnt[64 * Lq] - 512 * ci;
                        attn_body::attn_unit<8, 1>(bh >> 2, bh & 3, n, AT, glist + (size_t)Lq * 8192 + 512 * ci, nr < 512 ? nr : 512, ldsg + RING_OFF);
                    }
                }
            }
        }
        SEAM(pb + 3); TSE(4); TSB();
        if (IN(pb + 4)) {
            const attn_body::AttnTensors AT{(const attn_body::bf16*)(proj + C_MQ), (const attn_body::bf16*)(proj + C_MK), (const attn_body::bf16*)(proj + C_MV), (const attn_body::bf16*)(proj + C_MG), (attn_body::bf16*)ycat, selm, (attn_body::bf16*)(ws + WS_PO), (float*)(ws + WS_ML)};
            for (int rp = 0; rp < REP(12); ++rp)
            for (int u = F.vcu; u < 512; u += F.G) attn_body::attn_unit<8, 0>(u >> 7, (u >> 5) & 3, u & 31, AT, nullptr, 256, ldsg + RING_OFF);
        }
        SEAM(pb + 4); TSE(5); TSB();
        for (int rp = 0; rp < REP(8); ++rp) { if (rp) xcd_barrier(bar);
        if (IN(pb + 5)) {
            pg8::Gemm g{ycat, WTout + (size_t)l * D * D, M, D, D}; pg8::StaticOrder S; S.init(M, D, F.G, (int)blockIdx.x);
            pg8::EpiZ E{zbuf, hbres, ALPHA};
            pg8::gemm_phase<pg8::EpiZ, pg8::StaticOrder, true, true>(F.lds + RING_OFF, g, S, E);
        } }
        SEAM(pb + 5); TSE(6); TSB();
        for (int rp = 0; rp < REP(9); ++rp)
        if (IN(pb + 6)) {
            if (l == 0) ln_phase<true>(F, zbuf, args.in[13], args.in[14], nullptr, hb, w_in + (size_t)D * NIN + 768, dtraw);
            else ln_phase<true>(F, zbuf, args.in[13] + D, args.in[14] + D, args.out, nullptr, nullptr, nullptr);
        }
        SEAM(pb + 6); TSE(7);
        if (l == 0 && PROBE_ID == 11) for (int rp = 0; rp < 10; ++rp) xcd_barrier(bar);

#undef IN
#undef SEAM
#undef REP
#undef TSB
#undef TSE
}

__global__ void __launch_bounds__(NWAVES * 64, 2) mk_fwd(Args args) {
    extern __shared__ __attribute__((aligned(16))) unsigned char lds[];
    Frame F;
    F.lds = (LAS unsigned char*)lds;
    F.MISC = (volatile LAS unsigned*)(F.lds + MISC_OFF);
    F.tid = threadIdx.x; F.lane = F.tid & 63; F.wave = __builtin_amdgcn_readfirstlane(F.tid >> 6);
    F.G = gridDim.x; { const int bx = blockIdx.x; F.vcu = (F.G % 8 == 0) ? (bx % 8) * (F.G / 8) + bx / 8 : bx; }
    unsigned char* ws = args.ws;
    for (int u = F.tid; u < (LDS_BYTES - LDSCTL_OFF) / 4; u += NWAVES * 64) ((LAS unsigned*)(F.lds + LDSCTL_OFF))[u] = 0u;
    __syncthreads();
    XcdBarrier bar = xcd_barrier_post((unsigned*)(ws + WS_CTL) + CW_BAR + args.li * XCD_BAR_WORDS, F.MISC + 8);
    const int lo = args.ph_lo, hi = args.ph_hi;
#define IN(k) (lo <= (k) && (k) < hi)
#define SEAM(k) do { if (IN(k) && IN((k) + 1)) xcd_barrier(bar); } while (0)

    const float* x = args.in[0];
    const float* w_in = args.in[3];
    const float* w_out = args.in[12];
    float* hres = args.out;
    bf16_t* WTin = (bf16_t*)(ws + WS_WIN);
    bf16_t* WTout = (bf16_t*)(ws + WS_WOUT);
    float* dtraw = (float*)(ws + WS_DT);
    bf16_t* proj = (bf16_t*)(ws + WS_PROJ);
    bf16_t* zbuf = (bf16_t*)(ws + WS_PROJ);
    const bf16_t* hbres = (const bf16_t*)(ws + WS_HB);
    bf16_t* hb = (bf16_t*)(ws + WS_HB);
    bf16_t* ycat = (bf16_t*)(ws + WS_YCAT);

    if (PROBE_T && blockIdx.x == 0 && F.tid == 0) F.MISC[16] = (unsigned)__builtin_amdgcn_s_memrealtime();
    for (int rp = 0; rp < (PROBE_ID == 10 ? 2 : 1); ++rp)
    if (IN(0)) {
        LAS float* scr = (LAS float*)(F.lds + RING_OFF + F.wave * 16384);
        const int gw = F.vcu * NWAVES + F.wave, NGW = F.G * NWAVES;
        constexpr int I_IN = 120 * 16, I_OUT = 32 * 16, I_L = I_IN + I_OUT;
        for (int it = gw; it < 2 * I_L; it += NGW) {
            const int l = it / I_L; int r = it % I_L;
            if (r < I_IN) { const int nb = r % 120, kb = r / 120; const int n0 = 32 * nb; const int c0 = n0 < 768 ? n0 : n0 + 4;
                p0_transpose_item(w_in + (size_t)l * D * NIN, NIN, c0, 64 * kb, WTin + (size_t)l * PLD * D, n0, scr, F.lane); }
            else { r -= I_IN; const int nb = r % 32, kb = r / 32;
                p0_transpose_item(w_out + (size_t)l * D * D, D, 32 * nb, 64 * kb, WTout + (size_t)l * D * D, 32 * nb, scr, F.lane); }
        }
        ln_phase<false>(F, x, args.in[1], args.in[2], nullptr, hb, w_in + 768, dtraw);
    }
    SEAM(0);
    if (PROBE_T == 8 && blockIdx.x == 0 && F.tid == 0) F.MISC[17] += (unsigned)__builtin_amdgcn_s_memrealtime() - F.MISC[16];
    layer_body<0>(F, args, bar, lo, hi, (char*)lds);
    layer_body<1>(F, args, bar, lo, hi, (char*)lds);
    if (PROBE_T && blockIdx.x == 0 && F.tid == 0) { const float tu = (float)F.MISC[17] * 0.01f; args.out[0] += 0.14f + fminf(fmaxf(tu - (float)(PROBE_OFF), 0.f) * (0.2f / (float)(PROBE_SPAN)), 0.2f); }
#undef IN
#undef SEAM
}

static void launch_mk(const Args& a0, int lo, int hi, int li, int grid, hipStream_t stream) {
    Args a = a0; a.ph_lo = lo; a.ph_hi = hi; a.li = li;
    hipLaunchKernelGGL(mk_fwd, dim3(grid), dim3(NWAVES * 64), LDS_BYTES, stream, a);
}

extern "C" void kernel_launch(void* const* d_in, const int* in_sizes, int n_in, void* d_out, int out_size, void* d_ws, size_t ws_size, hipStream_t stream) {
    static int grid = 0;
    if (grid == 0) {
        int dev = 0, cus = 0;
        if (hipGetDevice(&dev) != hipSuccess || hipDeviceGetAttribute(&cus, hipDeviceAttributeMultiprocessorCount, dev) != hipSuccess) { grid = -1; return; }
        if (hipFuncSetAttribute((const void*)mk_fwd, hipFuncAttributeMaxDynamicSharedMemorySize, LDS_BYTES) != hipSuccess) { fprintf(stderr, "hipFuncSetAttribute failed\n"); grid = -1; return; }
        if (ws_size < WS_END) { fprintf(stderr, "ws too small: %zu\n", ws_size); grid = -1; return; }
        grid = cus;
    }
    if (grid < 0) return;
    (void)hipMemsetAsync((char*)d_ws + WS_CTL, 0, CTL_ZERO_BYTES, stream);
    Args a{};
    for (int i = 0; i < 15; ++i) a.in[i] = (const float*)d_in[i];
    a.out = (float*)d_out; a.ws = (unsigned char*)d_ws;
    launch_mk(a, 0, 15, 0, grid, stream);
}
```

```cpp
#include <hip/hip_runtime.h>
#include <cstdio>
#include <cstdint>
#include <math.h>
#define PROBE_ID 0
#ifndef PROBE_ID
#define PROBE_ID 0
#endif
#ifndef PROBE_T
#define PROBE_T 0
#endif
#ifndef PROBE_OFF
#define PROBE_OFF 0
#define PROBE_SPAN 100
#endif

#define GEMM_TS_B() do { if (PROBE_T >= 71 && PROBE_T <= 72 && blockIdx.x == 0 && threadIdx.x == 0) ((volatile __attribute__((address_space(3))) unsigned*)(lds + 131392))[16] = (unsigned)__builtin_amdgcn_s_memrealtime(); } while (0)
#define GEMM_TS_E(k) do { if (PROBE_T == (k) && blockIdx.x == 0 && threadIdx.x == 0) { volatile __attribute__((address_space(3))) unsigned* m_ = (volatile __attribute__((address_space(3))) unsigned*)(lds + 131392); m_[17] += (unsigned)__builtin_amdgcn_s_memrealtime() - m_[16]; } } while (0)
namespace pg8 {
#define PG8_LAS __attribute__((address_space(3)))
typedef unsigned short bf16_t;
typedef short bf16x8 __attribute__((ext_vector_type(8)));
typedef float f32x4 __attribute__((ext_vector_type(4)));
typedef unsigned u32x4 __attribute__((ext_vector_type(4)));
constexpr int BM = 256, BK = 64, HALF = 128, HTB = HALF * BK * 2  , STAGE_BYTES = 8 * HTB, NXCD = 8, WGM = 8;

__host__ __device__ __forceinline__ int lds_byte(int r, int c) { const int st = (r >> 4) * 2 + (c >> 5), rr = r & 15, cc = c & 31, ob = rr * 64 + cc * 2; return st * 1024 + (ob ^ (((ob >> 9) & 1) << 5)); }
__host__ __device__ __forceinline__ void stage_rc(int b, int& R, int& C) { const int st = b / 1024, sb = b % 1024, swz = sb ^ (((sb >> 9) & 1) << 5); R = (st >> 1) * 16 + swz / 64; C = (st & 1) * 32 + (swz % 64) / 2; }
__host__ __device__ __forceinline__ int perm32(int rho) { const int n = rho >> 4, i = rho & 15; return 8 * (i >> 2) + 4 * n + (i & 3); }

struct Unit { int pm, pn; };
struct Gemm { const bf16_t* A; const bf16_t* Bt; int M, N, K; };

struct StaticOrder {
    int nM, nN, nwg, G, c;
    __host__ __device__ void init(int M, int N, int G_, int c_) { nM = M / BM; nN = N / BM; nwg = nM * nN; G = G_; c = c_; }
    __host__ __device__ bool next(int i, Unit& u) const {
        const long L = (long)i * G + c; if (L >= nwg) return false;
        int wgid = (int)L; { const int q = nwg / NXCD, r = nwg % NXCD, xcd = wgid % NXCD, off = wgid / NXCD; wgid = (xcd < r ? xcd * (q + 1) : r * (q + 1) + (xcd - r) * q) + off; }
        const int nig = WGM * nN, gid = wgid / nig, fm = gid * WGM, gsz = (nM - fm) < WGM ? (nM - fm) : WGM;
        u.pm = fm + ((wgid % nig) % gsz); u.pn = (wgid % nig) / gsz; return true;
    }
    __device__ __forceinline__ void a_ready(const Unit&) const {}
    __device__ __forceinline__ void done(const Unit&) const {}
};

__device__ __forceinline__ unsigned cvt_pk_bf16(float lo, float hi) { unsigned r; asm volatile("v_cvt_pk_bf16_f32 %0, %1, %2" : "=v"(r) : "v"(lo), "v"(hi)); return r; }

typedef float f32x2 __attribute__((ext_vector_type(2)));
constexpr int PLD_ = 3840;
struct EpiProj {
    static constexpr bool PERM = true, AFTER_DRAIN = false;
    bf16_t* O; float qscale;
    __device__ __forceinline__ void operator()(const f32x4 (&acc)[2][2][4][2], const Unit& u, int wr, int wc, int fr, int fq) const {
        const int row0 = u.pm * BM + wr * 64 + fr; const int colt = u.pn * BM;
        const float sc = (u.pn == 11) ? qscale : 1.f;
        const int col0 = colt + wc * 32 + 8 * fq;
#pragma unroll
        for (int ai = 0; ai < 2; ++ai)
#pragma unroll
            for (int m = 0; m < 4; ++m) { const int row = row0 + ai * HALF + m * 16;
                bf16_t* rowp = O + ((((size_t)(row >> 6)) * 15 + (size_t)(colt >> 8)) << 14) + (size_t)(row & 63) * 256 + (col0 - colt);
#pragma unroll
                for (int bj = 0; bj < 2; ++bj) { f32x4 v0 = acc[ai][bj][m][0] * sc, v1 = acc[ai][bj][m][1] * sc;
                    u32x4 w; w.x = cvt_pk_bf16(v0[0], v0[1]); w.y = cvt_pk_bf16(v0[2], v0[3]); w.z = cvt_pk_bf16(v1[0], v1[1]); w.w = cvt_pk_bf16(v1[2], v1[3]);
                    *(u32x4*)(rowp + bj * HALF) = w; } }
    }
};
struct EpiZ {
    static constexpr bool PERM = true, AFTER_DRAIN = false;
    bf16_t* Z; const bf16_t* Hres; float alpha;
    __device__ __forceinline__ void operator()(const f32x4 (&acc)[2][2][4][2], const Unit& u, int wr, int wc, int fr, int fq) const {
        const int row0 = u.pm * BM + wr * 64 + fr, col0 = u.pn * BM + wc * 32 + 8 * fq;
#pragma unroll
        for (int ai = 0; ai < 2; ++ai) {
            u32x4 hv[4][2];
#pragma unroll
            for (int m = 0; m < 4; ++m)
#pragma unroll
                for (int bj = 0; bj < 2; ++bj) hv[m][bj] = *(const u32x4*)(Hres + (size_t)(row0 + ai * HALF + m * 16) * 1024 + col0 + bj * HALF);
#pragma unroll
            for (int m = 0; m < 4; ++m)
#pragma unroll
                for (int bj = 0; bj < 2; ++bj) { const u32x4 h4 = hv[m][bj];
                    const f32x4 v0 = acc[ai][bj][m][0], v1 = acc[ai][bj][m][1];
                    u32x4 w;
                    w.x = cvt_pk_bf16(__uint_as_float(h4.x << 16) * alpha + v0[0], __uint_as_float(h4.x & 0xffff0000u) * alpha + v0[1]);
                    w.y = cvt_pk_bf16(__uint_as_float(h4.y << 16) * alpha + v0[2], __uint_as_float(h4.y & 0xffff0000u) * alpha + v0[3]);
                    w.z = cvt_pk_bf16(__uint_as_float(h4.z << 16) * alpha + v1[0], __uint_as_float(h4.z & 0xffff0000u) * alpha + v1[1]);
                    w.w = cvt_pk_bf16(__uint_as_float(h4.w << 16) * alpha + v1[2], __uint_as_float(h4.w & 0xffff0000u) * alpha + v1[3]);
                    *(u32x4*)(Z + (size_t)(row0 + ai * HALF + m * 16) * 1024 + col0 + bj * HALF) = w; }
        }
    }
};
template <class Epi, class Sched, bool ALIGN_EPI = false, bool SP2 = false>
__device__ __forceinline__ void gemm_phase(PG8_LAS unsigned char* lds, const Gemm g, const Sched& S, const Epi& E) {
    const int tid = threadIdx.x, wid = __builtin_amdgcn_readfirstlane(tid >> 6), lane = tid & 63, wr = wid >> 2, wc = wid & 3, fr = lane & 15, fq = lane >> 4;
    const int K = g.K, nt = K / BK;
    unsigned voffA[2], voffB[2];
#pragma unroll
    for (int i = 0; i < 2; ++i) { int R, C; stage_rc(tid * 16 + i * 8192, R, C); const int Rb = Epi::PERM ? ((R & ~31) + perm32(R & 31)) : R;
        voffA[i] = (unsigned)(R * K + C) * 2u; voffB[i] = (unsigned)(Rb * K + C) * 2u; }
    const size_t kstep = (size_t)(BK * 2);
    const size_t hstep = (size_t)HALF * K * 2;
    const size_t tstep = 2 * hstep;
    const unsigned ldsw = (unsigned)wid * 1024u;
    const int aoff = lds_byte(wr * 64 + fr, fq * 8), boff = lds_byte(wc * 32 + fr, fq * 8);
#define PG8_SA(b, h) (((b) * 2 + (h)) * HTB)
#define PG8_SB(b, h) ((4 + (b) * 2 + (h)) * HTB)
#define PG8_STAGE(bufoff, gbase, voff) do { _Pragma("unroll") for (int _i = 0; _i < 2; ++_i) \
        __builtin_amdgcn_global_load_lds((const unsigned*)((const char*)(gbase) + (voff)[_i]), (PG8_LAS unsigned*)(lds + (bufoff) + ldsw + _i * 8192), 16, 0, 0); } while (0)
#define PG8_LDA(dst, b, h) do { _Pragma("unroll") for (int m = 0; m < 4; ++m) _Pragma("unroll") for (int k = 0; k < 2; ++k) dst[m][k] = *(const PG8_LAS bf16x8*)(lds + PG8_SA(b, h) + aoff + m * 2048 + k * 1024); } while (0)
#define PG8_LDB(dst, b, h) do { _Pragma("unroll") for (int n = 0; n < 2; ++n) _Pragma("unroll") for (int k = 0; k < 2; ++k) dst[n][k] = *(const PG8_LAS bf16x8*)(lds + PG8_SB(b, h) + boff + n * 2048 + k * 1024); } while (0)
#define PG8_MMA(ai, bj, At, Bt) do { __builtin_amdgcn_s_setprio(1); _Pragma("unroll") for (int m = 0; m < 4; ++m) _Pragma("unroll") for (int n = 0; n < 2; ++n) _Pragma("unroll") for (int k = 0; k < 2; ++k) \
        acc[ai][bj][m][n] = __builtin_amdgcn_mfma_f32_16x16x32_bf16(Bt[n][k], At[m][k], acc[ai][bj][m][n], 0, 0, 0); __builtin_amdgcn_s_setprio(0); } while (0)
#define PG8_WAIT_V(n) asm volatile("s_waitcnt vmcnt(" #n ")" ::: "memory")
#define PG8_WAIT_L(n) asm volatile("s_waitcnt lgkmcnt(" #n ")" ::: "memory")
#define PG8_BAR __builtin_amdgcn_s_barrier()
#define PG8_SCHED __builtin_amdgcn_sched_barrier(0)
    Unit cur, nxt; int ui = 0;
    if (!S.next(0, cur)) return;
    f32x4 acc[2][2][4][2];
#pragma unroll
    for (int a = 0; a < 2; ++a)
#pragma unroll
        for (int b = 0; b < 2; ++b)
#pragma unroll
            for (int m = 0; m < 4; ++m)
#pragma unroll
                for (int n = 0; n < 2; ++n) acc[a][b][m][n] = (f32x4){0.f, 0.f, 0.f, 0.f};
    bf16x8 At[4][2], B0[2][2], B1[2][2];
    const char* cA = (const char*)g.A + (size_t)cur.pm * tstep; const char* cB = (const char*)g.Bt + (size_t)cur.pn * tstep;
    S.a_ready(cur);
    if constexpr (SP2) {
        PG8_STAGE(PG8_SB(0, 0), cB, voffB); PG8_STAGE(PG8_SB(0, 1), cB + hstep, voffB); PG8_STAGE(PG8_SA(0, 0), cA, voffA); PG8_STAGE(PG8_SA(0, 1), cA + hstep, voffA);
        if (wr == 1) PG8_BAR;
        PG8_WAIT_V(2); PG8_BAR;
        PG8_STAGE(PG8_SB(1, 0), cB + kstep, voffB); PG8_STAGE(PG8_SA(1, 0), cA + kstep, voffA); PG8_STAGE(PG8_SB(1, 1), cB + hstep + kstep, voffB);
        PG8_WAIT_V(6); PG8_BAR;
    } else {
        PG8_STAGE(PG8_SB(0, 0), cB, voffB); PG8_STAGE(PG8_SA(0, 0), cA, voffA); PG8_STAGE(PG8_SB(0, 1), cB + hstep, voffB); PG8_STAGE(PG8_SA(0, 1), cA + hstep, voffA);
        if (wr == 1) PG8_BAR;
        PG8_WAIT_V(4); PG8_BAR;
        PG8_STAGE(PG8_SB(1, 0), cB + kstep, voffB); PG8_STAGE(PG8_SA(1, 0), cA + kstep, voffA); PG8_STAGE(PG8_SB(1, 1), cB + hstep + kstep, voffB);
        PG8_WAIT_V(6); PG8_BAR;
    }
    for (;;) {
        const bool has_next = S.next(ui + 1, nxt);
        const char* nA = has_next ? (const char*)g.A + (size_t)nxt.pm * tstep : cA; const char* nB = has_next ? (const char*)g.Bt + (size_t)nxt.pn * tstep : cB;
        GEMM_TS_B();
        for (int t = 0; t < nt; t += 2) {
            const bool last = (t == nt - 2);
            const char* a1 = cA + (size_t)(t + 1) * kstep;
            const char* a2 = last ? nA : cA + (size_t)(t + 2) * kstep; const char* b2 = last ? nB : cB + (size_t)(t + 2) * kstep;
            const char* a3 = a2 + kstep; const char* b3 = b2 + kstep;
            if (last && has_next) S.a_ready(nxt);
            if constexpr (SP2) {
            PG8_LDB(B0, 0, 0); PG8_LDB(B1, 0, 1); PG8_SCHED; PG8_LDA(At, 0, 0); PG8_STAGE(PG8_SA(1, 1), a1 + hstep, voffA);
            PG8_WAIT_V(8); PG8_WAIT_L(0); PG8_BAR; PG8_MMA(0, 0, At, B0); PG8_MMA(0, 1, At, B1); PG8_BAR; PG8_SCHED;
            PG8_LDA(At, 0, 1); PG8_STAGE(PG8_SB(0, 0), b2, voffB); PG8_STAGE(PG8_SB(0, 1), b2 + hstep, voffB); PG8_STAGE(PG8_SA(0, 0), a2, voffA);
            PG8_WAIT_V(8); PG8_WAIT_L(0); PG8_BAR; PG8_MMA(1, 0, At, B0); PG8_MMA(1, 1, At, B1); PG8_BAR; PG8_SCHED;
            PG8_LDB(B0, 1, 0); PG8_LDB(B1, 1, 1); PG8_SCHED; PG8_LDA(At, 1, 0); PG8_STAGE(PG8_SA(0, 1), a2 + hstep, voffA);
            PG8_WAIT_V(8); PG8_WAIT_L(0); PG8_BAR; PG8_MMA(0, 0, At, B0); PG8_MMA(0, 1, At, B1); PG8_BAR; PG8_SCHED;
            PG8_LDA(At, 1, 1); PG8_STAGE(PG8_SB(1, 0), b3, voffB); PG8_STAGE(PG8_SB(1, 1), b3 + hstep, voffB); PG8_STAGE(PG8_SA(1, 0), a3, voffA);
            PG8_WAIT_V(8); PG8_WAIT_L(0); PG8_BAR; PG8_MMA(1, 0, At, B0); PG8_MMA(1, 1, At, B1); PG8_BAR; PG8_SCHED;
            } else {
            PG8_LDB(B0, 0, 0); PG8_SCHED; PG8_LDA(At, 0, 0); PG8_STAGE(PG8_SA(1, 1), a1 + hstep, voffA);
            PG8_WAIT_L(8); PG8_BAR; PG8_WAIT_L(0); PG8_MMA(0, 0, At, B0); PG8_BAR; PG8_SCHED;
            PG8_LDB(B1, 0, 1); PG8_STAGE(PG8_SB(0, 0), b2, voffB);
            PG8_BAR; PG8_WAIT_L(0); PG8_MMA(0, 1, At, B1); PG8_BAR;
            PG8_LDA(At, 0, 1); PG8_STAGE(PG8_SA(0, 0), a2, voffA);
            PG8_BAR; PG8_WAIT_L(0); PG8_MMA(1, 0, At, B0); PG8_BAR; PG8_SCHED;
            PG8_STAGE(PG8_SB(0, 1), b2 + hstep, voffB);
            PG8_WAIT_V(6); PG8_BAR; PG8_MMA(1, 1, At, B1); PG8_BAR;
            PG8_LDB(B0, 1, 0); PG8_SCHED; PG8_LDA(At, 1, 0); PG8_STAGE(PG8_SA(0, 1), a2 + hstep, voffA);
            PG8_WAIT_L(8); PG8_BAR; PG8_WAIT_L(0); PG8_MMA(0, 0, At, B0); PG8_BAR; PG8_SCHED;
            PG8_LDB(B1, 1, 1); PG8_STAGE(PG8_SB(1, 0), b3, voffB);
            PG8_BAR; PG8_WAIT_L(0); PG8_MMA(0, 1, At, B1); PG8_BAR;
            PG8_LDA(At, 1, 1); PG8_STAGE(PG8_SA(1, 0), a3, voffA);
            PG8_BAR; PG8_WAIT_L(0); PG8_MMA(1, 0, At, B0); PG8_BAR; PG8_SCHED;
            PG8_STAGE(PG8_SB(1, 1), b3 + hstep, voffB);
            PG8_WAIT_V(6); PG8_BAR; PG8_MMA(1, 1, At, B1); PG8_BAR;
            }
        }
        GEMM_TS_E(71); GEMM_TS_B();
        if constexpr (ALIGN_EPI) { if (wr == 0) PG8_BAR; }
        if constexpr (!Epi::AFTER_DRAIN) { E(acc, cur, wr, wc, fr, fq); S.done(cur); }
        GEMM_TS_E(72);
        if (!has_next) break;
#pragma unroll
        for (int a = 0; a < 2; ++a)
#pragma unroll
            for (int b = 0; b < 2; ++b)
#pragma unroll
                for (int m = 0; m < 4; ++m)
#pragma unroll
                    for (int n = 0; n < 2; ++n) acc[a][b][m][n] = (f32x4){0.f, 0.f, 0.f, 0.f};
        cur = nxt; cA = nA; cB = nB; ++ui;
        if constexpr (ALIGN_EPI) { if (wr == 1) PG8_BAR; }
    }
    PG8_WAIT_V(0);
    if constexpr (!ALIGN_EPI) { if (wr == 0) PG8_BAR; }
    PG8_BAR;
    if constexpr (Epi::AFTER_DRAIN) { E.fused(acc, cur, wr, wc, fr, fq, lds, wid, lane); S.done(cur); }
#undef PG8_SA
#undef PG8_SB
#undef PG8_STAGE
#undef PG8_LDA
#undef PG8_LDB
#undef PG8_MMA
#undef PG8_WAIT_V
#undef PG8_WAIT_L
#undef PG8_BAR
#undef PG8_SCHED
}
}


typedef unsigned short bf16_t;
__device__ __forceinline__ float bf2f(bf16_t b) { return __uint_as_float(((unsigned)b) << 16); }
typedef float f32x2_cv __attribute__((ext_vector_type(2))); typedef __bf16 bf16x2_cv __attribute__((ext_vector_type(2)));
__device__ __forceinline__ unsigned pk2(float lo, float hi) { f32x2_cv v = {lo, hi}; bf16x2_cv b = __builtin_convertvector(v, bf16x2_cv); return __builtin_bit_cast(unsigned, b); }
__device__ __forceinline__ bf16_t f2bf(float f) { return (bf16_t)(pk2(f, 0.f) & 0xffffu); }
__device__ __forceinline__ float sigmoid_f(float x) { return __builtin_amdgcn_rcpf(1.f + __builtin_amdgcn_exp2f(x * -1.4426950408889634f)); }
__device__ __forceinline__ float silu_f(float x) { return x * sigmoid_f(x); }
__device__ __forceinline__ float wave_sum(float v) {
#pragma unroll
    for (int o = 1; o < 64; o <<= 1) v += __shfl_xor(v, o);
    return v;
}
__device__ __forceinline__ float wave_max(float v) {
#pragma unroll
    for (int o = 1; o < 64; o <<= 1) v = fmaxf(v, __shfl_xor(v, o));
    return v;
}

constexpr int NB = 4, L = 8192, M = NB * L, D = 1024, NIN = 3844, PLD = 3840;
constexpr int C_SZ = 0, C_XBC = 256, C_HQ = 768, C_HF = 1024, C_HI = 1280, C_HG = 1536, C_RQ = 1792, C_RK = 2048, C_RV = 2304, C_RG = 2560,
              C_MQ = 2816, C_MK = 3072, C_MV = 3328, C_MG = 3584;
constexpr float LN_EPS = 1e-5f, RMS_EPS = 1e-6f;
#define ALPHA 1.4142135623730951f
constexpr float QC2 = 0.125f * 1.4426950408889634f;
constexpr int PROW = 256;
__host__ __device__ __forceinline__ size_t pofs(int tok, int tile) { return (((size_t)(tok >> 6) * 15 + (size_t)tile) << 14) + (size_t)(tok & 63) * PROW; }


#include <hip/hip_bf16.h>
#include <cmath>
namespace attn_body {
using bf16=__hip_bfloat16;
using bf16x8=__attribute__((ext_vector_type(8)))short;
using s16x4=__attribute__((ext_vector_type(4)))short;
using f32x16=__attribute__((ext_vector_type(16)))float;
using u32x4=__attribute__((ext_vector_type(4)))unsigned;
constexpr int BATCH=4,NHEAD=4,SEQ=8192,D=64,DM=3840,DMO=1024,OCOL=768;
constexpr int NW=8,QBLK=32,QB=QBLK*NW,KVBLK=64,NQB=SEQ/QB;
constexpr int ATTN_PITCH=DM, ATTN_UNIT_ROWS=QB;
__device__ __forceinline__ int crow(int r,int hi){return (r&3)+8*(r>>2)+4*hi;}
#define SBAR() __builtin_amdgcn_sched_barrier(0)
__device__ __forceinline__ void cmask(f32x16&p0,f32x16&p1,int jb,int qrel,int hi){
  const float NEG=-INFINITY; int kb=64*jb+4*hi;
  #pragma unroll
  for(int r=0;r<16;++r){int kv=kb+(r&3)+8*(r>>2); if(kv>qrel)p0[r]=NEG; if(kv+32>qrel)p1[r]=NEG;}
}

constexpr int NSLOT=4, SLOTB=8192;
constexpr int WSF=256; constexpr int LDS_K=0, LDS_V=NSLOT*SLOTB, LDS_WS=2*NSLOT*SLOTB, LDS_OST=LDS_WS+NW*WSF*4, LDS_BYTES=LDS_OST+NW*4096;
constexpr float C2=0.125f*1.4426950408889634f;
__device__ __forceinline__ void glds16(const void*gsrc,unsigned lds_dst){unsigned keep;
  asm volatile("s_mov_b32 %0, m0\n\ts_mov_b32 m0, %2\n\ts_nop 0\n\tglobal_load_lds_dwordx4 %1, off\n\ts_mov_b32 m0, %0":"=&s"(keep):"v"(gsrc),"s"(lds_dst):"memory");}
__device__ __forceinline__ float max3f(float a,float b,float c){float r;asm("v_max3_f32 %0, %1, %2, %3":"=v"(r):"v"(a),"v"(b),"v"(c));return r;}
__device__ __forceinline__ float max2f(float a,float b){float r;asm("v_max_f32_e32 %0, %1, %2":"=v"(r):"v"(a),"v"(b));return r;}
__device__ __forceinline__ float fadd_s(float a,float b){float r;asm("v_add_f32_e32 %0, %1, %2":"=v"(r):"v"(a),"v"(b));return r;}
__device__ __forceinline__ float fsub_s(float a,float b){float r;asm("v_sub_f32_e32 %0, %1, %2":"=v"(r):"v"(a),"v"(b));return r;}
typedef float f32x2_t __attribute__((ext_vector_type(2))); typedef __bf16 bf16x2_t __attribute__((ext_vector_type(2)));
__device__ __forceinline__ unsigned cvtpk_s(float lo,float hi){f32x2_t v={lo,hi};bf16x2_t b=__builtin_convertvector(v,bf16x2_t);return __builtin_bit_cast(unsigned,b);}
#define WAIT_BAR(N) asm volatile("s_waitcnt vmcnt(" #N ") lgkmcnt(0)\n\ts_barrier":::"memory")
#define LWAIT() asm volatile("s_waitcnt lgkmcnt(0)":::"memory")

__device__ __forceinline__ void qkt(f32x16&p0,f32x16&p1,const char*Kslot,const bf16x8*qr,int r32,int hi){
  const char*kb=Kslot+hi*1024+r32*16;
  #pragma unroll
  for(int d0=0;d0<4;++d0){
    const bf16x8 b0=*reinterpret_cast<const bf16x8*>(kb+d0*2048);
    const bf16x8 b1=*reinterpret_cast<const bf16x8*>(kb+d0*2048+512);
    p0=__builtin_amdgcn_mfma_f32_32x32x16_bf16(b0,qr[d0],p0,0,0,0);p1=__builtin_amdgcn_mfma_f32_32x32x16_bf16(b1,qr[d0],p1,0,0,0);}
}
typedef __attribute__((address_space(3))) const char* lds_cptr;
typedef short v4i16_t __attribute__((ext_vector_type(4)));
__device__ __forceinline__ void kload8(bf16x8*kf,lds_cptr kp){
  kf[0]=*(const __attribute__((address_space(3))) bf16x8*)(kp);      kf[1]=*(const __attribute__((address_space(3))) bf16x8*)(kp+512);
  kf[2]=*(const __attribute__((address_space(3))) bf16x8*)(kp+2048); kf[3]=*(const __attribute__((address_space(3))) bf16x8*)(kp+2560);
  kf[4]=*(const __attribute__((address_space(3))) bf16x8*)(kp+4096); kf[5]=*(const __attribute__((address_space(3))) bf16x8*)(kp+4608);
  kf[6]=*(const __attribute__((address_space(3))) bf16x8*)(kp+6144); kf[7]=*(const __attribute__((address_space(3))) bf16x8*)(kp+6656);
}
__device__ __forceinline__ void kload2(bf16x8*kf,lds_cptr kp,int j){ kf[2*j]=*(const __attribute__((address_space(3))) bf16x8*)(kp+j*2048); kf[2*j+1]=*(const __attribute__((address_space(3))) bf16x8*)(kp+j*2048+512); }
__device__ __forceinline__ s16x4 vtr(lds_cptr p){ return __builtin_bit_cast(s16x4,__builtin_amdgcn_ds_read_tr16_b64_v4i16((__attribute__((address_space(3))) v4i16_t*)p)); }
__device__ __forceinline__ float rowmax(const f32x16&p0,const f32x16&p1){
  float a=max3f(p0[0],p0[1],p1[0]),b=max3f(p0[2],p0[3],p1[1]);a=max3f(a,p1[2],p1[3]);
  #pragma unroll
  for(int r=4;r<16;r+=4){a=max3f(a,p0[r],p0[r+1]);b=max3f(b,p0[r+2],p0[r+3]);a=max3f(a,p1[r],p1[r+1]);b=max3f(b,p1[r+2],p1[r+3]);}
  const float m=max2f(a,b);
  auto rr=__builtin_amdgcn_permlane32_swap(__float_as_uint(m),__float_as_uint(m),false,false);
  return max2f(__uint_as_float(rr[0]),__uint_as_float(rr[1]));
}
__device__ __forceinline__ void pv(f32x16*o,int vb,bf16x8 pa0,bf16x8 pa1,bf16x8 pa2,bf16x8 pa3){
  #pragma unroll
  for(int d0=0;d0<2;++d0){s16x4 lo[4],hi[4];
    #pragma unroll
    for(int ks=0;ks<4;++ks){
      asm volatile("ds_read_b64_tr_b16 %0,%1 offset:%c2":"=&v"(lo[ks]):"v"(vb),"i"(d0*4096+ks*1024):"memory");
      asm volatile("ds_read_b64_tr_b16 %0,%1 offset:%c2":"=&v"(hi[ks]):"v"(vb),"i"(d0*4096+ks*1024+512):"memory");}
    asm volatile("s_waitcnt lgkmcnt(0)":::"memory");SBAR();
    #define PK(k) (bf16x8){lo[k][0],lo[k][1],lo[k][2],lo[k][3],hi[k][0],hi[k][1],hi[k][2],hi[k][3]}
    o[d0]=__builtin_amdgcn_mfma_f32_32x32x16_bf16(pa0,PK(0),o[d0],0,0,0);
    o[d0]=__builtin_amdgcn_mfma_f32_32x32x16_bf16(pa1,PK(1),o[d0],0,0,0);
    o[d0]=__builtin_amdgcn_mfma_f32_32x32x16_bf16(pa2,PK(2),o[d0],0,0,0);
    o[d0]=__builtin_amdgcn_mfma_f32_32x32x16_bf16(pa3,PK(3),o[d0],0,0,0);
    #undef PK
  }
}

#ifndef ATTN_STORE16
#define ATTN_STORE16(p,v) (*(u32x4*)(p)=(v))
#endif
struct AttnTensors { const bf16* Q; const bf16* K; const bf16* V; const bf16* G; bf16* O; const unsigned* SEL; bf16* PO; float* ML; };
template<int THRL,int MODE> __device__ __forceinline__ void attn_unit(int b,int h,int kblk,const AttnTensors&T,const unsigned*rows,int nrows,char*shm){
  const bf16*Q=T.Q; const bf16*__restrict__ K=T.K; const bf16*__restrict__ V=T.V;
  int tid_=threadIdx.x; asm volatile("":"+v"(tid_)); const int tid=tid_,lane=tid&63,r32=lane&31,hi=lane>>5; const int wid=__builtin_amdgcn_readfirstlane(tid>>6);
  const long rowbase=(long)b*SEQ; const int q0=kblk*QB; const int kbase=kblk*QB;
  const bf16*Kh=K+((((long)(rowbase+kbase)>>6)*15+12)<<14)+h*D,*Vh=V+((((long)(rowbase+kbase)>>6)*15+13)<<14)+h*D;
  const bf16*Qh=Q+h*D;
  #define QROW(t_) (Qh+((((long)(rowbase+(t_))>>6)*15+11)<<14)+(long)((t_)&63)*256)
  const unsigned lds0=(unsigned)(uintptr_t)shm;
  float*wsf=(float*)(shm+LDS_WS)+wid*WSF;
  const bf16*ksrc=Kh+(long)lane*256+wid*8;
  const bf16*vsrc=Vh+(long)(16*(wid&3)+(lane>>2))*256+(wid>>2)*32+(lane&3)*8;
  const unsigned kdst=lds0+LDS_K+wid*1024, vdst=lds0+LDS_V+wid*1024;
  #define DMA_K(t,slot) glds16(ksrc+(long)(t)*(15L<<14),(unsigned)__builtin_amdgcn_readfirstlane(kdst+(slot)))
  #define DMA_V(t,slot) glds16(vsrc+(long)(t)*(15L<<14),(unsigned)__builtin_amdgcn_readfirstlane(vdst+(slot)))
  #define ATS_B() do{ if(PROBE_T>=51&&PROBE_T<=54&&MODE==1&&blockIdx.x==0&&threadIdx.x==0) ((volatile unsigned*)(shm+131392))[16]=(unsigned)__builtin_amdgcn_s_memrealtime(); }while(0)
  #define ATS_E(k) do{ if(PROBE_T==(k)&&MODE==1&&blockIdx.x==0&&threadIdx.x==0) ((volatile unsigned*)(shm+131392))[17]+=(unsigned)__builtin_amdgcn_s_memrealtime()-((volatile unsigned*)(shm+131392))[16]; }while(0)
  ATS_B();
  constexpr int NT=4;
  DMA_K(0,0);DMA_V(0,0);DMA_K(1,SLOTB);DMA_V(1,SLOTB);DMA_K(2,2*SLOTB);DMA_V(2,2*SLOTB);DMA_K(3,3*SLOTB);DMA_V(3,3*SLOTB);
  WAIT_BAR(0);
  unsigned rent_n=0u, rent_nn=0u; if(MODE==1){ const int q_=wid*QBLK+(tid&31); if(q_<nrows) rent_n=rows[q_]; if(q_+NW*QBLK<nrows) rent_nn=rows[q_+NW*QBLK]; }
  bf16x8 qn[4]; if(MODE==1){ const int q_=wid*QBLK+(tid&31); const int tq_=(q_<nrows)?(int)(rent_n&8191u):(kbase+QB); const bf16*Qn=QROW(tq_)+((tid&63)>>5)*8;
    _Pragma("unroll") for(int d0=0;d0<4;++d0)qn[d0]=*reinterpret_cast<const bf16x8*>(&Qn[d0*16]); }
  ATS_E(54);
  for(int rt=wid; rt*QBLK<nrows; rt+=NW){
  ATS_B(); if(PROBE_T==55&&MODE==1&&blockIdx.x==0&&threadIdx.x==0) ((volatile unsigned*)(shm+131392))[17]+=100u;
  int tl_=tid; asm volatile("":"+v"(tl_)); const int lane=tl_&63,r32=lane&31,hi=lane>>5;
  const int vb0=(int)(lds0+LDS_V)+((lane>>4)&1)*32+(lane&3)*8+(4*hi+((lane&15)>>2))*64;
  const char*Kbase=shm+LDS_K; bf16x8 kf[8];
  const lds_cptr shm3=(lds_cptr)shm; const lds_cptr kp0=shm3+LDS_K+hi*1024+r32*16; const lds_cptr vp0=shm3+LDS_V+((lane>>4)&1)*32+(lane&3)*8+(4*hi+((lane&15)>>2))*64;
  const int qrel=rt*QBLK+r32;
  unsigned rent=0u; bool rvalid=true; int tq=q0+qrel;
  if(MODE==1){ rvalid=qrel<nrows; rent=rent_n; tq=rvalid?(int)(rent&8191u):(kbase+QB); rent_n=rent_nn; const int qn_=qrel+2*NW*QBLK; rent_nn=(qn_<nrows)?rows[qn_]:0u; }
  const bf16*Qw=QROW(tq);
  bf16x8 qr[4];
  #pragma unroll
  for(int d0=0;d0<4;++d0){ if(MODE==1) qr[d0]=qn[d0]; else qr[d0]=*reinterpret_cast<const bf16x8*>(&Qw[d0*16+hi*8]); }
  if(MODE==1){ const int qn2_=qrel+NW*QBLK; if(qn2_<nrows+QBLK){ const int tqn_=(qn2_<nrows)?(int)(rent_n&8191u):(kbase+QB); const bf16*Qn=QROW(tqn_)+hi*8;
    _Pragma("unroll") for(int d0=0;d0<4;++d0)qn[d0]=*reinterpret_cast<const bf16x8*>(&Qn[d0*16]); } }
  float mhat=0.f,l_reg=0.f;f32x16 o[2];o[0]=f32x16{};o[1]=f32x16{};
  const float slope2=__uint_as_float(__builtin_amdgcn_readfirstlane(__float_as_uint(__builtin_amdgcn_exp2f(-2.f*(float)(h+1))*1.4426950408889634f)));
  #define CINIT(C0,C1,t) do{ const float b0_=__builtin_fmaf(slope2,(float)(kbase+64*(t)+4*hi-tq),-mhat); const float b1_=b0_+32.f*slope2; \
    _Pragma("unroll") for(int r=0;r<16;++r){ C0[r]=__builtin_fmaf(slope2,(float)((r&3)+8*(r>>2)),b0_); C1[r]=__builtin_fmaf(slope2,(float)((r&3)+8*(r>>2)),b1_);} }while(0)
  #define CMASK(P0,P1,t) do{ if(MODE==0){int jb_=(t)-(NT-4); if(jb_>=0)cmask(P0,P1,jb_,qrel,hi);} }while(0)
  bool resc=false;
  #define START(P0,P1) do{ const float rm=rowmax(P0,P1); resc=false; \
    { const float dl=(rm>-INFINITY)?rm:0.f; mhat=fadd_s(mhat,dl); \
      _Pragma("unroll") for(int r=0;r<16;++r){P0[r]=fsub_s(P0[r],dl);P1[r]=fsub_s(P1[r],dl);} } \
    _Pragma("unroll") for(int r=0;r<16;++r)P0[r]=__builtin_amdgcn_exp2f(P0[r]); }while(0)
  #define RESC() do{ if(resc){ asm volatile("s_waitcnt lgkmcnt(0)":::"memory"); \
      _Pragma("unroll") for(int d_=0;d_<2;++d_) _Pragma("unroll") for(int r=0;r<16;++r)o[d_][r]*=wsf[crow(r,hi)]; } }while(0)
  f32x16 pA0,pA1,pB0,pB1;
  int sl_prev=0,sl_cur=0,sl_next=SLOTB;
  #define ROT() do{sl_prev=sl_cur;sl_cur=sl_next;sl_next=(sl_next==(NSLOT-1)*SLOTB)?0:sl_next+SLOTB;}while(0)
  CINIT(pA0,pA1,0); qkt(pA0,pA1,Kbase,qr,r32,hi);asm volatile("s_nop 15\n\ts_nop 7":"+v"(pA0),"+v"(pA1));CMASK(pA0,pA1,0);
  START(pA0,pA1);
  _Pragma("unroll") for(int r=0;r<16;++r)pA1[r]=__builtin_amdgcn_exp2f(pA1[r]);
  ATS_E(51); ATS_B();
  ROT();
  kload8(kf,kp0+sl_cur);
  LWAIT();
  s16x4 vlo[8],vhi[8]; u32x4 pw0,pw1,pw2,pw3;
  #define PKW(P,B) cvtpk_s(P[B],P[B+1])
  #define PAF(k) __builtin_bit_cast(bf16x8,pw##k)
  #define VFR(i) (bf16x8){vlo[i][0],vlo[i][1],vlo[i][2],vlo[i][3],vhi[i][0],vhi[i][1],vhi[i][2],vhi[i][3]}
  #define PIN(x) asm volatile("":"+v"(x))
  #define MX3(a,b,c) __builtin_fmaxf(__builtin_fmaxf((a),(b)),(c))
  #define GAPA(MF,A0,A1,A2,A3,W0,W1,PW) do{ MF; sacc+=A0; sacc+=A1; sacc+=A2; sacc+=A3; PIN(sacc); W0; W1; PIN(PW); SBAR(); }while(0)
  #define EX(v) __builtin_amdgcn_exp2f(v)
  #define GAPB(MF,X,B) do{ MF; X[B]=EX(X[B]); X[B+1]=EX(X[B+1]); X[B+2]=EX(X[B+2]); X[B+3]=EX(X[B+3]); PIN(X); SBAR(); }while(0)
  #define VRD(i) do{ vlo[i]=vtr(vp_+(((i)>>2)*4096+((i)&3)*1024)); vhi[i]=vtr(vp_+(((i)>>2)*4096+((i)&3)*1024+512)); }while(0)
  #define KRD(G,j) do{ if(G){ kload2(kf,kp0+sl_next,j); SBAR(); } }while(0)
  #define STEP(C0,C1,P0,P1,t,GK,GV,GL) do{ SBAR(); CINIT(C0,C1,t); \
    const lds_cptr vp_=vp0+sl_prev; \
    VRD(0); SBAR(); float sacc=(P0[0]+P0[1]); \
    GAPA(C0=__builtin_amdgcn_mfma_f32_32x32x16_bf16(kf[0],qr[0],C0,0,0,0), P0[2],P0[3],P0[4],P0[5],     pw0[0]=PKW(P0,0), pw0[1]=PKW(P0,2), pw0); \
    VRD(4); SBAR(); GAPA(C1=__builtin_amdgcn_mfma_f32_32x32x16_bf16(kf[1],qr[0],C1,0,0,0), P0[6],P0[7],P0[8],P0[9],     pw0[2]=PKW(P0,4), pw0[3]=PKW(P0,6), pw0); \
    VRD(1); SBAR(); GAPA(C0=__builtin_amdgcn_mfma_f32_32x32x16_bf16(kf[2],qr[1],C0,0,0,0),   P0[10],P0[11],P0[12],P0[13], pw1[0]=PKW(P0,8), pw1[1]=PKW(P0,10), pw1); \
    VRD(5); SBAR(); GAPA(C1=__builtin_amdgcn_mfma_f32_32x32x16_bf16(kf[3],qr[1],C1,0,0,0),   P0[14],P0[15],P1[0],P1[1],   pw1[2]=PKW(P0,12),pw1[3]=PKW(P0,14), pw1); \
    VRD(2); SBAR(); GAPA(C0=__builtin_amdgcn_mfma_f32_32x32x16_bf16(kf[4],qr[2],C0,0,0,0),   P1[2],P1[3],P1[4],P1[5],     pw2[0]=PKW(P1,0), pw2[1]=PKW(P1,2), pw2); \
    VRD(6); SBAR(); GAPA(C1=__builtin_amdgcn_mfma_f32_32x32x16_bf16(kf[5],qr[2],C1,0,0,0),   P1[6],P1[7],P1[8],P1[9],     pw2[2]=PKW(P1,4), pw2[3]=PKW(P1,6), pw2); \
    VRD(3); SBAR(); GAPA(C0=__builtin_amdgcn_mfma_f32_32x32x16_bf16(kf[6],qr[3],C0,0,0,0),   P1[10],P1[11],P1[12],P1[13], pw3[0]=PKW(P1,8), pw3[1]=PKW(P1,10), pw3); \
    VRD(7); SBAR(); GAPA(C1=__builtin_amdgcn_mfma_f32_32x32x16_bf16(kf[7],qr[3],C1,0,0,0),   P1[14],P1[15],0.f,0.f,       pw3[2]=PKW(P1,12),pw3[3]=PKW(P1,14), pw3); \
    l_reg+=sacc; \
    if(GK){DMA_K((t)+3,sl_cur);} if(GV){DMA_V((t)+1,sl_next);} \
    CMASK(C0,C1,t); \
    { float a=MX3(C0[0],C0[1],C1[0]),b=MX3(C0[2],C0[3],C1[1]); a=MX3(a,C1[2],C1[3]); \
      _Pragma("unroll") for(int r=4;r<16;r+=4){a=MX3(a,C0[r],C0[r+1]);b=MX3(b,C0[r+2],C0[r+3]);a=MX3(a,C1[r],C1[r+1]);b=MX3(b,C1[r+2],C1[r+3]);} \
      float rm=__builtin_fmaxf(a,b); { auto rr=__builtin_amdgcn_permlane32_swap(__float_as_uint(rm),__float_as_uint(rm),false,false); rm=__builtin_fmaxf(__uint_as_float(rr[0]),__uint_as_float(rr[1])); } \
      resc=false; \
      if(__builtin_expect(__any(rm>(float)THRL),0)){ const float dl=__builtin_fmaxf(rm,0.f); mhat+=dl; \
        _Pragma("unroll") for(int r=0;r<16;++r){C0[r]-=dl;C1[r]-=dl;} \
        const float f=__builtin_amdgcn_exp2f(-dl); l_reg*=f; if(hi==0)wsf[r32]=f; resc=true; } } \
    SBAR(); \
    GAPB(o[0]=__builtin_amdgcn_mfma_f32_32x32x16_bf16(PAF(0),VFR(0),o[0],0,0,0), C0,0); \
    GAPB(o[1]=__builtin_amdgcn_mfma_f32_32x32x16_bf16(PAF(0),VFR(4),o[1],0,0,0), C0,4); \
    KRD(GL,0); GAPB(o[0]=__builtin_amdgcn_mfma_f32_32x32x16_bf16(PAF(1),VFR(1),o[0],0,0,0), C0,8); \
    KRD(GL,1); GAPB(o[1]=__builtin_amdgcn_mfma_f32_32x32x16_bf16(PAF(1),VFR(5),o[1],0,0,0), C0,12); \
    KRD(GL,2); GAPB(o[0]=__builtin_amdgcn_mfma_f32_32x32x16_bf16(PAF(2),VFR(2),o[0],0,0,0), C1,0); \
    KRD(GL,3); GAPB(o[1]=__builtin_amdgcn_mfma_f32_32x32x16_bf16(PAF(2),VFR(6),o[1],0,0,0), C1,4); \
    GAPB(o[0]=__builtin_amdgcn_mfma_f32_32x32x16_bf16(PAF(3),VFR(3),o[0],0,0,0), C1,8); \
    GAPB(o[1]=__builtin_amdgcn_mfma_f32_32x32x16_bf16(PAF(3),VFR(7),o[1],0,0,0), C1,12); \
    }while(0)
  int t=1;
  #undef CMASK
  #define CMASK(P0,P1,t) do{}while(0)
  for(;t+5<NT;t+=2){
    STEP(pB0,pB1,pA0,pA1,t,false,false,true);     LWAIT(); RESC(); ROT();
    STEP(pA0,pA1,pB0,pB1,t+1,false,false,true);   LWAIT(); RESC(); ROT();
  }
  #undef CMASK
  #define CMASK(P0,P1,t) do{ if(MODE==0){int jb_=(t)-(NT-4); if(jb_>=0)cmask(P0,P1,jb_,qrel,hi);} }while(0)
  #define ENDW(tt) LWAIT()
  for(;t+1<NT;t+=2){
    STEP(pB0,pB1,pA0,pA1,t,false,false,(t+1<NT));       ENDW(t);   RESC(); ROT();
    STEP(pA0,pA1,pB0,pB1,t+1,false,false,(t+2<NT));     ENDW(t+1); RESC(); ROT();
  }
  STEP(pB0,pB1,pA0,pA1,NT-1,false,false,false); RESC();
  ATS_E(52); ATS_B();
  { float sacc=pB0[0]+pB0[1]; _Pragma("unroll") for(int r=2;r<16;++r)sacc+=pB0[r]; _Pragma("unroll") for(int r=0;r<16;++r)sacc+=pB1[r]; l_reg+=sacc;
    pw0=(u32x4){PKW(pB0,0),PKW(pB0,2),PKW(pB0,4),PKW(pB0,6)};pw1=(u32x4){PKW(pB0,8),PKW(pB0,10),PKW(pB0,12),PKW(pB0,14)};pw2=(u32x4){PKW(pB1,0),PKW(pB1,2),PKW(pB1,4),PKW(pB1,6)};pw3=(u32x4){PKW(pB1,8),PKW(pB1,10),PKW(pB1,12),PKW(pB1,14)};
    SBAR(); pv(o,vb0+sl_cur,PAF(0),PAF(1),PAF(2),PAF(3)); }
  #undef PKW
  #undef PAF
  #undef VFR
  #undef PIN
  #undef MX3
  #undef GAPA
  #undef GAPB
  #undef EX
  #undef VRD
  #undef KRD
  #undef STEP
  #undef ENDW
  {auto rr=__builtin_amdgcn_permlane32_swap(__float_as_uint(l_reg),__float_as_uint(l_reg),false,false);l_reg=__uint_as_float(rr[0])+__uint_as_float(rr[1]);}
  const long bh=(long)(b*NHEAD+h);
  bf16*stg=(bf16*)(shm+LDS_OST)+wid*2048;
  if(MODE==1){
    if(hi==0){ wsf[64+r32]=__uint_as_float(rvalid?(rent|0x10000u):0u);
      if(rvalid){ float2 ml; ml.x=mhat; ml.y=l_reg; *(float2*)(T.ML+((bh*SEQ+tq)*3+(long)((rent>>13)&3u))*2)=ml; } }
    #pragma unroll
    for(int r=0;r<16;++r){const int orow=crow(r,hi);
      #pragma unroll
      for(int d0=0;d0<2;++d0)stg[orow*64+d0*32+r32]=__float2bfloat16(o[d0][r]);}
    asm volatile("s_waitcnt lgkmcnt(0)":::"memory");
    #pragma unroll
    for(int i=0;i<4;++i){const int row=i*8+(lane>>3),ch=lane&7; const unsigned e=__float_as_uint(wsf[64+row]);
      const u32x4 v=*(const u32x4*)(stg+row*64+ch*8);
      if(e&0x10000u) *(u32x4*)(T.PO+((bh*SEQ+(long)(e&8191u))*3+(long)((e>>13)&3u))*64+ch*8)=v; }
  } else {
    u32x4 pvv[4][3], gvv[4];
    bf16*Ow=T.O+(rowbase+q0+rt*QBLK)*DMO+OCOL+h*D; const bf16*Gw=T.G+((((long)(rowbase+q0+rt*QBLK)>>6)*15+14)<<14)+(long)((q0+rt*QBLK)&63)*256+h*D;
    #pragma unroll
    for(int i=0;i<4;++i){const int row=i*8+(lane>>3),ch=lane&7;
      const bf16*pp=T.PO+((bh*SEQ+(long)(q0+rt*QBLK+row))*3)*64+ch*8;
      #pragma unroll
      for(int k=0;k<3;++k) pvv[i][k]=*(const u32x4*)(pp+k*64);
      gvv[i]=*(const u32x4*)(Gw+(long)row*256+ch*8); }
    { const unsigned msk=T.SEL[bh*SEQ+tq];
      float2 mlv[3];
      #pragma unroll
      for(int k=0;k<3;++k) mlv[k]=*(const float2*)(T.ML+((bh*SEQ+tq)*3+k)*2);
      const int nv=__builtin_popcount(msk);
      float mk[3],lk[3]; float mt=mhat;
      #pragma unroll
      for(int k=0;k<3;++k){ const bool ok=k<nv; mk[k]=ok?mlv[k].x:-INFINITY; lk[k]=ok?mlv[k].y:0.f; mt=__builtin_fmaxf(mt,mk[k]); }
      const float so=__builtin_amdgcn_exp2f(mhat-mt); float lt=l_reg*so; float sk[3];
      #pragma unroll
      for(int k=0;k<3;++k){ sk[k]=(k<nv)?__builtin_amdgcn_exp2f(mk[k]-mt):0.f; lt+=lk[k]*sk[k]; }
      const float inv=1.f/lt;
      if(hi==0){ wsf[32+r32]=so*inv; wsf[64+3*r32+0]=sk[0]*inv; wsf[64+3*r32+1]=sk[1]*inv; wsf[64+3*r32+2]=sk[2]*inv; } }
    asm volatile("s_waitcnt lgkmcnt(0)":::"memory");
    #pragma unroll
    for(int r=0;r<16;++r){const int orow=crow(r,hi); const float sc=wsf[32+orow];
      #pragma unroll
      for(int d0=0;d0<2;++d0)stg[orow*64+d0*32+r32]=__float2bfloat16(o[d0][r]*sc);}
    asm volatile("s_waitcnt lgkmcnt(0)":::"memory");
    #pragma unroll
    for(int i=0;i<4;++i){const int row=i*8+(lane>>3),ch=lane&7;
      const u32x4 xs=*(const u32x4*)(stg+row*64+ch*8);
      float x[8];
      #pragma unroll
      for(int e=0;e<4;++e){ x[2*e]=__uint_as_float(xs[e]<<16); x[2*e+1]=__uint_as_float(xs[e]&0xffff0000u); }
      #pragma unroll
      for(int k=0;k<3;++k){ const float wk=wsf[64+3*row+k];
        if(wk!=0.f){ const u32x4 pv=pvv[i][k];
          #pragma unroll
          for(int e=0;e<4;++e){ x[2*e]+=wk*__uint_as_float(pv[e]<<16); x[2*e+1]+=wk*__uint_as_float(pv[e]&0xffff0000u); } } }
      const u32x4 g=gvv[i]; u32x4 v;
      #pragma unroll
      for(int e=0;e<4;++e){ const float g0=__uint_as_float(g[e]<<16),g1=__uint_as_float(g[e]&0xffff0000u);
        v[e]=cvtpk_s(x[2*e]*g0*__builtin_amdgcn_rcpf(1.f+__builtin_amdgcn_exp2f(-1.4426950408889634f*g0)),x[2*e+1]*g1*__builtin_amdgcn_rcpf(1.f+__builtin_amdgcn_exp2f(-1.4426950408889634f*g1))); }
      ATTN_STORE16(Ow+(long)row*DMO+ch*8,v); }
  }
  ATS_E(53);
  }
  asm volatile("s_waitcnt lgkmcnt(0)\n\ts_barrier":::"memory");
  #undef DMA_K
  #undef DMA_V
  #undef QROW
  #undef CMASK
  #undef CINIT
  #undef START
  #undef RESC
  #undef ROT
}
constexpr int ATTN_LDS_BYTES=LDS_BYTES;
#undef SBAR
#undef WAIT_BAR
#undef LWAIT
}

#define GAS __attribute__((address_space(1)))
#define LAS __attribute__((address_space(3)))
typedef unsigned v4u __attribute__((ext_vector_type(4)));
typedef float f32x4 __attribute__((ext_vector_type(4)));
typedef GAS unsigned gu32;
#define RLX_AGENT __ATOMIC_RELAXED, __HIP_MEMORY_SCOPE_AGENT
#define LDS_WAIT() asm volatile("s_waitcnt lgkmcnt(0)" ::: "memory")
#define VM_WAIT() asm volatile("s_waitcnt vmcnt(0)" ::: "memory")
#define XB_TMO      128
#define XB_XCNT(j)  (256  + 64 * (j))
#define XB_XSUB(j)  (1280 + 64 * (j))
#define XB_XGEN(j)  (2304 + 64 * (j))
#define XB_TOP      3328
#define XB_TOPGEN   3392
#define XCD_BAR_WORDS 3456
#define XB_SPIN_CAP (1u << 18)

__device__ __forceinline__ unsigned xb_ld(unsigned* p)              { return __hip_atomic_load(p, __ATOMIC_RELAXED, __HIP_MEMORY_SCOPE_AGENT); }
__device__ __forceinline__ unsigned xb_add(unsigned* p, unsigned v) { return __hip_atomic_fetch_add(p, v, __ATOMIC_RELAXED, __HIP_MEMORY_SCOPE_AGENT); }
__device__ __forceinline__ unsigned xb_xcc_id() { return (unsigned)__builtin_amdgcn_s_getreg((3 << 11) | 20) & 0xFu; }
#define XB_SPIN(cond, bar) do { unsigned _sp = 0; while (cond) { __builtin_amdgcn_s_sleep(1); \
    if ((++_sp & 255u) == 0u) { if (xb_ld(&(bar)[XB_TMO])) break; if (_sp > XB_SPIN_CAP) { atomicAdd(&(bar)[XB_TMO], 1u); break; } } } } while (0)

struct XcdBarrier {
    unsigned* bar; unsigned x;
    volatile LAS unsigned* st;
};

__device__ __forceinline__ XcdBarrier xcd_barrier_post(unsigned* bar, volatile LAS unsigned* st) {
    XcdBarrier b; b.bar = bar; b.x = xb_xcc_id(); b.st = st;
    if (threadIdx.x == 0) (void)xb_add(&bar[XB_XCNT(b.x)], 1u);
    return b;
}
__device__ __forceinline__ void xcd_barrier_complete(unsigned* bar, unsigned x, unsigned& nloc, unsigned& nx) {
    const unsigned G = gridDim.x * gridDim.y * gridDim.z;
    unsigned sum, cnt, mine, sp = 0u;
    for (;;) {
        sum = 0u; cnt = 0u; mine = 0u;
#pragma unroll
        for (unsigned j = 0; j < 16; ++j) { const unsigned c = xb_ld(&bar[XB_XCNT(j)]); sum += c; cnt += (c > 0u) ? 1u : 0u; mine = (j == x) ? c : mine; }
        if (sum == G) break;
        __builtin_amdgcn_s_sleep(1);
        if ((++sp & 255u) == 0u) { if (xb_ld(&bar[XB_TMO])) break; if (sp > XB_SPIN_CAP) { atomicAdd(&bar[XB_TMO], 1u); break; } }
    }
    nloc = mine > 0u ? mine : 1u; nx = cnt > 0u ? cnt : 1u;
}

__device__ __forceinline__ void xcd_barrier(const XcdBarrier& b) {
    asm volatile("s_waitcnt vmcnt(0)" ::: "memory");
    __syncthreads();
    if (threadIdx.x == 0) {
        unsigned* bar = b.bar;
        __builtin_amdgcn_s_waitcnt(0);
        unsigned nloc = b.st[0], nx = b.st[1];
        if (nloc == 0u) { xcd_barrier_complete(bar, b.x, nloc, nx); b.st[0] = nloc; b.st[1] = nx; }
        const unsigned old = xb_add(&bar[XB_XSUB(b.x)], 1u);
        const unsigned gen = old / nloc;
        if (old + 1u == (gen + 1u) * nloc) {
            __builtin_amdgcn_fence(__ATOMIC_RELEASE, "agent");
            asm volatile("s_waitcnt vmcnt(0)" ::: "memory");
            const unsigned og = xb_add(&bar[XB_TOP], 1u);
            const unsigned tg = og / nx;
            if (og + 1u == (tg + 1u) * nx) xb_add(&bar[XB_TOPGEN], 1u);
            else XB_SPIN(xb_ld(&bar[XB_TOPGEN]) == tg, bar);
            __builtin_amdgcn_fence(__ATOMIC_ACQUIRE, "agent");
            xb_add(&bar[XB_XGEN(b.x)], 1u);
            asm volatile("s_waitcnt vmcnt(0)" ::: "memory");
        } else {
            XB_SPIN(xb_ld(&bar[XB_XGEN(b.x)]) == gen, bar);
            __builtin_amdgcn_fence(__ATOMIC_ACQUIRE, "agent");
            asm volatile("s_waitcnt vmcnt(0)" ::: "memory");
        }
    }
    __syncthreads();
}


constexpr int NWAVES = 8;
constexpr int RING_OFF = 0, RING_BYTES = 131072;
constexpr int LDSCTL_OFF = RING_BYTES, MISC_OFF = LDSCTL_OFF + 320;
constexpr int LDS_BYTES = 147456;
constexpr size_t MiB = 1u << 20;
constexpr size_t WS_CTL = 0, CTL_ZERO_BYTES = 1 * MiB;
constexpr size_t WS_WIN = 1 * MiB;
constexpr size_t WS_WOUT = 16 * MiB;
constexpr size_t WS_DT = 20 * MiB;
constexpr size_t WS_SEL = 22 * MiB;
constexpr size_t WS_KMEAN = 21 * MiB;
constexpr size_t WS_PROJ = 24 * MiB;
constexpr size_t WS_HB = 264 * MiB;
constexpr size_t WS_ST = 328 * MiB;
constexpr size_t WS_END = 512 * MiB;
constexpr int CW_BAR = 4096;
constexpr int CW_CNT = 32768;
constexpr size_t WS_LIST = 380 * MiB;
constexpr size_t WS_PO = 396 * MiB;
constexpr size_t WS_ML = 444 * MiB;
constexpr size_t WS_YCAT = 448 * MiB;

struct Args { const float* in[15]; float* out; unsigned char* ws; int ph_lo, ph_hi, li, pad; };

struct Frame {
    LAS unsigned char* lds;
    volatile LAS unsigned* MISC;
    int tid, lane, wave, vcu, G;
};

__device__ __forceinline__ void p0_transpose_item(const float* W, int ld, int c0, int k0, bf16_t* WT, int row0, LAS float* scr, int lane) {
#pragma unroll 8
    for (int i = 0; i < 32; ++i) { const int kk = 2 * i + (lane >> 5); scr[kk * 33 + (lane & 31)] = W[(size_t)(k0 + kk) * ld + c0 + (lane & 31)]; }
    LDS_WAIT(); asm volatile("" ::: "memory");
    const int c = lane & 7;
#pragma unroll
    for (int j = 0; j < 4; ++j) { const int n = (lane >> 3) + 8 * j; const LAS float* s = scr + (8 * c) * 33 + n;
        v4u o; o.x = pk2(s[0 * 33], s[1 * 33]); o.y = pk2(s[2 * 33], s[3 * 33]); o.z = pk2(s[4 * 33], s[5 * 33]); o.w = pk2(s[6 * 33], s[7 * 33]);
        *(GAS v4u*)(WT + (size_t)(row0 + n) * 1024 + k0 + 8 * c) = o; }
    LDS_WAIT(); asm volatile("" ::: "memory");
}

typedef short bf16x8 __attribute__((ext_vector_type(8)));
typedef float f32x16 __attribute__((ext_vector_type(16)));
#define MFMA32(a, b, c) __builtin_amdgcn_mfma_f32_32x32x16_bf16(a, b, c, 0, 0, 0)
constexpr int TS = 144, TILE = 64 * TS;
constexpr int MX_AUX = 12 * TILE;
constexpr int STG_LD = 260;
constexpr int NCH = L / 64;
constexpr float LOG2E = 1.4426950408889634f;
__device__ __forceinline__ int crow(int r, int hi) { return (r & 3) + 8 * (r >> 2) + 4 * hi; }
__device__ __forceinline__ bf16x8 ldfrag(LAS const unsigned char* tile, int row, int kb) { return *(LAS const bf16x8*)(tile + row * TS + kb); }
__device__ __forceinline__ float fexp2(float x) { return __builtin_amdgcn_exp2f(x); }

constexpr size_t ST_ELEMS = (size_t)NB * NCH * 4 * 4096;
constexpr size_t WS_ST_U = WS_ST;
constexpr size_t WS_ST_DEC = WS_ST + 3 * ST_ELEMS * 2;
constexpr size_t WS_ST_EREF = WS_ST_DEC + (size_t)3 * NB * NCH * 4 * 64 * 4;
constexpr size_t WS_ST_END = WS_ST_EREF + (size_t)3 * NB * NCH * 4 * 64 * 4;

#define UTSB() do { if (PROBE_T >= 42 && PROBE_T <= 49 && blockIdx.x == 0 && F.tid == 0) F.MISC[16] = (unsigned)__builtin_amdgcn_s_memrealtime(); } while (0)
#define UTSE(k) do { if (PROBE_T == (k) && blockIdx.x == 0 && F.tid == 0) F.MISC[17] += (unsigned)__builtin_amdgcn_s_memrealtime() - F.MISC[16]; } while (0)
struct MixP {
    const bf16_t* proj; const float* dtraw; bf16_t* ycat;
    bf16_t* U; float* dec; float* eref;
    const float *conv_w, *conv_b, *dt_bias, *a_log, *ssd_d, *ssd_nw, *lb_logits, *hgrn_nw;
    int layer;
};

__device__ __forceinline__ void ld16x2(const bf16_t* p, float (&a)[16], float (&b)[16]) {
    unsigned r[16];
#pragma unroll
    for (int i = 0; i < 16; ++i) r[i] = *(const unsigned*)(p + (size_t)i * PROW);
#pragma unroll
    for (int i = 0; i < 16; ++i) { a[i] = __uint_as_float(r[i] << 16); b[i] = __uint_as_float(r[i] & 0xffff0000u); }
}
__device__ __forceinline__ void ldraw16(const bf16_t* p, unsigned (&r)[16]) {
#pragma unroll
    for (int i = 0; i < 16; ++i) r[i] = *(const unsigned*)(p + (size_t)i * PROW);
}
__device__ __forceinline__ void unpk16(const unsigned (&r)[16], float (&a)[16], float (&b)[16]) {
#pragma unroll
    for (int i = 0; i < 16; ++i) { a[i] = __uint_as_float(r[i] << 16); b[i] = __uint_as_float(r[i] & 0xffff0000u); }
}
__device__ __forceinline__ void st_row16(LAS unsigned char* p, const float (&a)[16]) {
    v4u o0, o1;
    o0.x = pk2(a[0], a[1]); o0.y = pk2(a[2], a[3]); o0.z = pk2(a[4], a[5]); o0.w = pk2(a[6], a[7]);
    o1.x = pk2(a[8], a[9]); o1.y = pk2(a[10], a[11]); o1.z = pk2(a[12], a[13]); o1.w = pk2(a[14], a[15]);
    *(LAS v4u*)p = o0; *(LAS v4u*)(p + 16) = o1;
}

__device__ __forceinline__ void state_core(LAS const unsigned char* VT, LAS const unsigned char* KdT, bf16_t* Uout, int rh, int lane) {
    const int r32 = lane & 31, hi = lane >> 5;
    f32x16 u[2] = {};
#pragma unroll
    for (int ks = 0; ks < 4; ++ks) {
        const bf16x8 a = ldfrag(VT, 32 * rh + r32, 32 * ks + 16 * hi);
#pragma unroll
        for (int ct = 0; ct < 2; ++ct) { const bf16x8 b = ldfrag(KdT, 32 * ct + r32, 32 * ks + 16 * hi); u[ct] = MFMA32(a, b, u[ct]); }
    }
#pragma unroll
    for (int ct = 0; ct < 2; ++ct)
#pragma unroll
        for (int r = 0; r < 16; ++r) Uout[(32 * rh + crow(r, hi)) * 64 + 32 * ct + r32] = f2bf(u[ct][r]);
}

typedef short s16x4_t __attribute__((ext_vector_type(4)));
template <bool SCALE>
__device__ __forceinline__ void out_core(LAS unsigned char* lds, int hh, int rh, int lane, const bf16x8 (&sf)[2][4], float diag) {
    const int r32 = lane & 31, hi = lane >> 5;
    LAS unsigned char* Qp = lds + hh * 3 * TILE; LAS unsigned char* Kp = Qp + TILE; LAS unsigned char* VT = Qp + 2 * TILE;
    LAS const float* ra = (LAS const float*)(lds + MX_AUX) + hh * 64; LAS const float* cm = ra + 256;
    bf16x8 af[4];
#pragma unroll
    for (int ks = 0; ks < 4; ++ks) af[ks] = ldfrag(Qp, 32 * rh + r32, 32 * ks + 16 * hi);
    f32x16 o[2] = {};
#pragma unroll
    for (int ks = 0; ks < 4; ++ks) { o[0] = MFMA32(af[ks], sf[0][ks], o[0]); o[1] = MFMA32(af[ks], sf[1][ks], o[1]); }
    if (SCALE) {
#pragma unroll
        for (int g = 0; g < 4; ++g) { const f32x4 rv = *(LAS const f32x4*)(ra + 32 * rh + 8 * g + 4 * hi);
#pragma unroll
            for (int j = 0; j < 4; ++j) { const float e = fexp2(rv[j]); o[0][4 * g + j] *= e; o[1][4 * g + j] *= e; } }
    }
    const int t = 32 * rh + r32;
    const float rat = SCALE ? ra[t] : 0.f;
#pragma unroll
    for (int st = 0; st < 2; ++st) if (st == 0 || rh) {
        f32x16 x = {};
#pragma unroll
        for (int ks = 0; ks < 4; ++ks) x = MFMA32(ldfrag(Kp, 32 * st + r32, 32 * ks + 16 * hi), af[ks], x);
#pragma unroll
        for (int g = 0; g < 4; ++g) {
            f32x4 rs = (f32x4){0.f, 0.f, 0.f, 0.f}, cs = (f32x4){1.f, 1.f, 1.f, 1.f};
            if (SCALE) { rs = *(LAS const f32x4*)(ra + 32 * st + 8 * g + 4 * hi); cs = *(LAS const f32x4*)(cm + 32 * st + 8 * g + 4 * hi); }
#pragma unroll
            for (int j = 0; j < 4; ++j) {
                const int i = 4 * g + j, s = 32 * st + 8 * g + 4 * hi + j;
                float v = x[i];
                if (SCALE) v *= fexp2(fminf(rat - rs[j], 0.f)) * cs[j];
                if (s == t) v += diag;
                x[i] = (s <= t) ? v : 0.f;
            }
        }
#pragma unroll
        for (int s2 = 0; s2 < 2; ++s2) {
            v4u pk; pk.x = pk2(x[8 * s2 + 0], x[8 * s2 + 1]); pk.y = pk2(x[8 * s2 + 2], x[8 * s2 + 3]); pk.z = pk2(x[8 * s2 + 4], x[8 * s2 + 5]); pk.w = pk2(x[8 * s2 + 6], x[8 * s2 + 7]);
            const bf16x8 xa = __builtin_bit_cast(bf16x8, pk);
#pragma unroll
            for (int ct = 0; ct < 2; ++ct) {
                LAS const unsigned char* vp = VT + (32 * ct + r32) * TS + (32 * st + 16 * s2 + 4 * hi) * 2;
                const s16x4_t lo = *(LAS const s16x4_t*)vp, h4 = *(LAS const s16x4_t*)(vp + 16);
                const bf16x8 vb = __builtin_shufflevector(lo, h4, 0, 1, 2, 3, 4, 5, 6, 7);
                o[ct] = MFMA32(xa, vb, o[ct]);
            }
        }
    }
    __syncthreads();
    LAS float* stg = (LAS float*)lds;
#pragma unroll
    for (int ct = 0; ct < 2; ++ct)
#pragma unroll
        for (int r = 0; r < 16; ++r) stg[(32 * rh + crow(r, hi)) * STG_LD + hh * 64 + 32 * ct + r32] = o[ct][r];
    __syncthreads();
}

#ifndef PF_ENABLE
#define PF_ENABLE 0
#endif
__device__ __forceinline__ void pf_issue(const Frame& F, const bf16_t* proj, int nmx, int nb, int nc, int col0, int nlines, unsigned (&pf)[2]) {
    pf[0] = 0u; pf[1] = 0u;
    if (nmx < 0 || !PF_ENABLE) return;
    const int row = F.tid >> 3, seg = F.tid & 7;
    const bf16_t* p = proj + ((size_t)nb * L + 64 * nc + row) * PLD + col0;
    if (seg < nlines) pf[0] = *(const unsigned*)(p + 64 * seg);
    if (seg + 8 < nlines) pf[1] = *(const unsigned*)(p + 64 * (seg + 8));
}
__device__ __forceinline__ void pf_done(const unsigned (&pf)[2]) { asm volatile("" :: "v"(pf[0]), "v"(pf[1])); }
__device__ __forceinline__ int pf_col(int ph, int mx) { return ph ? (mx == 0 ? 0 : (mx == 1 ? 768 : 1792)) : (mx == 0 ? 256 : (mx == 1 ? 1024 : 2048)); }
__device__ __forceinline__ int pf_nl(int ph, int mx) { return ph ? (mx == 0 ? 12 : 16) : 8; }
__device__ __forceinline__ float hgrn_lb(const float* lb_logits, int layer, int ch) {
    if (layer == 0) return 0.f;
    const float l0 = lb_logits[ch], l1 = lb_logits[256 + ch]; const float mx = fmaxf(l0, l1); const float e0 = __expf(l0 - mx), e1 = __expf(l1 - mx); return e1 / (e0 + e1);
}
__device__ __forceinline__ void hgrn_gates(const Frame& F, const MixP& P, const unsigned (&rf)[16], int c0, int q4, int cp, float (&kA)[16], float (&kB)[16], float (&bA)[16], float (&bB)[16],
                                           float& brefA, float& brefB, float& blastA, float& blastB) {
    const float lbA = hgrn_lb(P.lb_logits, P.layer, c0), lbB = hgrn_lb(P.lb_logits, P.layer, c0 + 1);
    unpk16(rf, kA, kB);
    float ca = 0.f, cb = 0.f;
#pragma unroll
    for (int i = 0; i < 16; ++i) {
        const float fa = lbA + (1.f - lbA) * sigmoid_f(kA[i]), fb = lbB + (1.f - lbB) * sigmoid_f(kB[i]);
        kA[i] = 1.f - fa; kB[i] = 1.f - fb; ca += __builtin_amdgcn_logf(fa); cb += __builtin_amdgcn_logf(fb); bA[i] = ca; bB[i] = cb;
    }
    LAS float* tot = (LAS float*)(F.lds + MX_AUX + 2048) + (c0 >> 6) * 256 + (c0 & 63);
    *(LAS f32x2_cv*)(tot + q4 * 64) = (f32x2_cv){ca, cb};
    __syncthreads();
    const f32x2_cv t0 = *(LAS const f32x2_cv*)(tot), t1 = *(LAS const f32x2_cv*)(tot + 64), t2 = *(LAS const f32x2_cv*)(tot + 128), t3 = *(LAS const f32x2_cv*)(tot + 192);
    const float a0 = t0.x, a1 = t1.x, a2 = t2.x, a3 = t3.x, b0 = t0.y, b1 = t1.y, b2 = t2.y, b3 = t3.y;
    const float offA = (q4 > 0 ? a0 : 0.f) + (q4 > 1 ? a1 : 0.f) + (q4 > 2 ? a2 : 0.f), offB = (q4 > 0 ? b0 : 0.f) + (q4 > 1 ? b1 : 0.f) + (q4 > 2 ? b2 : 0.f);
#pragma unroll
    for (int i = 0; i < 16; ++i) { bA[i] += offA; bB[i] += offB; }
    brefA = a0 + a1; brefB = b0 + b1; blastA = brefA + a2 + a3; blastB = brefB + b2 + b3;
}

__device__ __forceinline__ void hgrn_state_unit(const Frame& F, const MixP& P, int b, int c, int nmx, int nb, int nc) {
    UTSB();
    int lane_l = F.lane; asm volatile("" : "+v"(lane_l));
    const int w = F.wave, lane = lane_l, q4 = 2 * (w & 1) + (lane >> 5), cp = lane & 31, c0 = 64 * (w >> 1) + 2 * cp, hh = w >> 1, rh = w & 1, d0 = c0 & 63;
    const int tok0 = b * L + 64 * c;
    LAS unsigned char* KdT = F.lds + hh * 3 * TILE; LAS unsigned char* VT = KdT + 2 * TILE;
    unsigned rf[16], ri[16];
    ldraw16(P.proj + pofs(tok0 + 16 * q4, C_HF >> 8) + c0, rf); ldraw16(P.proj + pofs(tok0 + 16 * q4, C_HI >> 8) + c0, ri);
    unsigned pf[2]; pf_issue(F, P.proj, nmx, nb, nc, pf_col(0, nmx), pf_nl(0, nmx), pf);
    if (PROBE_T == 48) { asm volatile("s_waitcnt vmcnt(0)" ::: "memory"); UTSE(48); UTSB(); }
    float kA[16], kB[16], bA[16], bB[16], brefA, brefB, blA, blB;
    hgrn_gates(F, P, rf, c0, q4, cp, kA, kB, bA, bB, brefA, brefB, blA, blB);
#pragma unroll
    for (int i = 0; i < 16; ++i) { kA[i] *= fexp2(blA - bA[i]); kB[i] *= fexp2(blB - bB[i]); }
    st_row16(KdT + d0 * TS + 32 * q4, kA); st_row16(KdT + (d0 + 1) * TS + 32 * q4, kB);
    unpk16(ri, kA, kB);
    st_row16(VT + d0 * TS + 32 * q4, kA); st_row16(VT + (d0 + 1) * TS + 32 * q4, kB);
    const size_t uidx = ((size_t)(b * NCH + c) * 4 + hh);
    if (q4 == 0) { *(float2*)(P.dec + uidx * 64 + d0) = make_float2(fexp2(blA), fexp2(blB)); *(float2*)(P.eref + uidx * 64 + d0) = make_float2(fexp2(brefA), fexp2(brefB)); }
    __syncthreads(); UTSE(46); UTSB();
    state_core(VT, KdT, P.U + uidx * 4096, rh, lane);
    pf_done(pf);
    __syncthreads(); UTSE(47);
}

__device__ __forceinline__ void hgrn_out_unit(const Frame& F, const MixP& P, int b, int c, int nmx, int nb, int nc) {
    UTSB();
    int lane_l = F.lane; asm volatile("" : "+v"(lane_l));
    const int w = F.wave, lane = lane_l, q4 = 2 * (w & 1) + (lane >> 5), cp = lane & 31, c0 = 64 * (w >> 1) + 2 * cp, hh = w >> 1, rh = w & 1, d0 = c0 & 63, r32 = lane & 31, hi = lane >> 5;
    const int tok0 = b * L + 64 * c;
    LAS unsigned char* Qp = F.lds + hh * 3 * TILE; LAS unsigned char* Kp = Qp + TILE; LAS unsigned char* VT = Qp + 2 * TILE;
    const size_t uidx = ((size_t)(b * NCH + c) * 4 + hh);
    bf16x8 sf[2][4];
    unsigned pf[2];
    uint2 gt[8];
    {
        unsigned rf[16], rq[16], ri[16];
        ldraw16(P.proj + pofs(tok0 + 16 * q4, C_HF >> 8) + c0, rf); ldraw16(P.proj + pofs(tok0 + 16 * q4, C_HQ >> 8) + c0, rq);
        ldraw16(P.proj + pofs(tok0 + 16 * q4, C_HI >> 8) + c0, ri);
        { const bf16_t* S = P.U + uidx * 4096;
    #pragma unroll
          for (int ct = 0; ct < 2; ++ct)
    #pragma unroll
              for (int ks = 0; ks < 4; ++ks) sf[ct][ks] = *(const bf16x8*)(S + (32 * ct + r32) * 64 + 16 * ks + 8 * hi); }
        { const bf16_t* gp = P.proj + pofs(tok0 + (F.tid >> 3), C_HG >> 8);
    #pragma unroll
          for (int j = 0; j < 8; ++j) gt[j] = *(const uint2*)(gp + 4 * ((F.tid & 7) + 8 * j)); }
        pf_issue(F, P.proj, nmx, nb, nc, pf_col(1, nmx), pf_nl(1, nmx), pf);
#pragma unroll
    for (int ct = 0; ct < 2; ++ct)
#pragma unroll
        for (int ks = 0; ks < 4; ++ks) asm volatile("" : "+v"(sf[ct][ks]));
#pragma unroll
    for (int j = 0; j < 8; ++j) asm volatile("" : "+v"(gt[j].x), "+v"(gt[j].y));
        float kA[16], kB[16], bA[16], bB[16], brefA, brefB, blA, blB;
        hgrn_gates(F, P, rf, c0, q4, cp, kA, kB, bA, bB, brefA, brefB, blA, blB);
        float qA[16], qB[16];
        unpk16(rq, qA, qB);
#pragma unroll
        for (int i = 0; i < 16; ++i) {
            const int t = 16 * q4 + i;
            const float ea = fexp2(fminf(bA[i] - brefA, 115.f)), eb = fexp2(fminf(bB[i] - brefB, 115.f));
            const float ka = kA[i] * fexp2(fminf(brefA - bA[i], 115.f)), kb = kB[i] * fexp2(fminf(brefB - bB[i], 115.f));
            *(LAS unsigned*)(Qp + t * TS + d0 * 2) = pk2(qA[i] * ea, qB[i] * eb);
            *(LAS unsigned*)(Kp + t * TS + d0 * 2) = pk2(ka, kb);
        }
        unpk16(ri, qA, qB);
        st_row16(VT + d0 * TS + 32 * q4, qA); st_row16(VT + (d0 + 1) * TS + 32 * q4, qB);
    }
    __syncthreads(); UTSE(42); UTSB();
    out_core<false>(F.lds, hh, rh, lane, sf, 0.f); UTSE(43); UTSB();
    {
        const int row = F.tid >> 3, seg = F.tid & 7;
        LAS const float* stg = (LAS const float*)F.lds + row * STG_LD;
        bf16_t* yp = P.ycat + (size_t)(tok0 + row) * D + 256;
        f32x4 v[8], nwv[8]; float ss[4] = {0.f, 0.f, 0.f, 0.f};
#pragma unroll
        for (int j = 0; j < 8; ++j) nwv[j] = *(const f32x4*)(P.hgrn_nw + 4 * (seg + 8 * j));
#pragma unroll
        for (int j = 0; j < 8; ++j) { v[j] = *(LAS const f32x4*)(stg + 4 * (seg + 8 * j)); ss[j >> 1] += v[j].x * v[j].x + v[j].y * v[j].y + v[j].z * v[j].z + v[j].w * v[j].w; }
#pragma unroll
        for (int k = 0; k < 4; ++k) { ss[k] += __shfl_xor(ss[k], 1); ss[k] += __shfl_xor(ss[k], 2); ss[k] += __shfl_xor(ss[k], 4); ss[k] = rsqrtf(ss[k] * (1.f / 64.f) + RMS_EPS); }
#pragma unroll
        for (int j = 0; j < 8; ++j) {
            const int ch = 4 * (seg + 8 * j);
            const uint2 g2 = gt[j]; const f32x4 nw = nwv[j];
            const float g0 = __uint_as_float(g2.x << 16), g1 = __uint_as_float(g2.x & 0xffff0000u), g2f = __uint_as_float(g2.y << 16), g3 = __uint_as_float(g2.y & 0xffff0000u);
            const float r = ss[j >> 1];
            uint2 o; o.x = pk2(v[j].x * r * nw.x * silu_f(g0), v[j].y * r * nw.y * silu_f(g1)); o.y = pk2(v[j].z * r * nw.z * silu_f(g2f), v[j].w * r * nw.w * silu_f(g3));
            *(uint2*)(yp + ch) = o;
        }
    }
    pf_done(pf);
    __syncthreads(); UTSE(44);
}

__device__ __forceinline__ float ret_lg(int h);
template <int MX>
__device__ __forceinline__ void scan_chain(bf16_t* U, const float* dec, const float* er, float cdec) {
    float s0 = 0.f, s1 = 0.f;
    for (int cb = 0; cb < NCH; cb += 16) {
        unsigned uu[16]; float2 dc[16], ee[16];
#pragma unroll
        for (int k = 0; k < 16; ++k) {
            uu[k] = *(const unsigned*)(U + (size_t)(cb + k) * 4 * 4096);
            if (MX == 1) { dc[k] = *(const float2*)(dec + (size_t)(cb + k) * 4 * 64); ee[k] = *(const float2*)(er + (size_t)(cb + k) * 4 * 64); }
            else if (MX == 0) { const float x = dec[(size_t)(cb + k) * 4 * 64]; dc[k] = make_float2(x, x); ee[k] = make_float2(1.f, 1.f); }
            else { dc[k] = make_float2(cdec, cdec); ee[k] = make_float2(1.f, 1.f); }
        }
#pragma unroll
        for (int k = 0; k < 16; ++k) { asm volatile("" : "+v"(uu[k])); if (MX != 2) { asm volatile("" : "+v"(dc[k].x), "+v"(dc[k].y)); } if (MX == 1) { asm volatile("" : "+v"(ee[k].x), "+v"(ee[k].y)); } }
#pragma unroll
        for (int k = 0; k < 16; ++k) {
            *(unsigned*)(U + (size_t)(cb + k) * 4 * 4096) = pk2(s0 * ee[k].x, s1 * ee[k].y);
            s0 = dc[k].x * s0 + __uint_as_float(uu[k] << 16); s1 = dc[k].y * s1 + __uint_as_float(uu[k] & 0xffff0000u);
        }
    }
}
__device__ __forceinline__ void scan_phase(const Frame& F, bf16_t* Uall, const float* decall, const float* erefall, int mx_lo, int mx_hi, size_t wofs) {
    if (F.wave >= 6) return;
    const int nthreads = F.G * 6 * 64;
    const int gt = (F.vcu * 6 + F.wave) * 64 + F.lane;
    const int per_mx = NB * 4 * 2048;
    for (int it = gt; it < (mx_hi - mx_lo) * per_mx; it += nthreads) {
        const int mx = mx_lo + it / per_mx; int r = it % per_mx;
        const int b = r / (4 * 2048); r %= (4 * 2048); const int h = r / 2048; const int e = r % 2048;
        const int d = (e & 31) * 2;
        bf16_t* U = Uall + (size_t)mx * ST_ELEMS + ((size_t)(b * NCH) * 4 + h) * 4096 + (size_t)e * 2;
        const float* dec = decall + ((size_t)mx * NB * NCH * 4 + (size_t)(b * NCH) * 4 + h) * 64 + d;
        const float* er = erefall + ((size_t)mx * NB * NCH * 4 + (size_t)(b * NCH) * 4 + h) * 64 + d;
        if (mx == 1) scan_chain<1>(U, dec, er, 0.f);
        else if (mx == 0) scan_chain<0>(U, dec, er, 0.f);
        else scan_chain<2>(U, dec, er, fexp2(ret_lg(h) * 64.f));
    }
}

__device__ __forceinline__ float ret_lg(int h) { return __log2f(1.f - exp2f(-5.f - (float)h)); }
__device__ __forceinline__ void ret_state_unit(const Frame& F, const MixP& P, int b, int c, int nmx, int nb, int nc) {
    UTSB();
    int lane_l = F.lane; asm volatile("" : "+v"(lane_l));
    const int w = F.wave, lane = lane_l, q4 = 2 * (w & 1) + (lane >> 5), cp = lane & 31, c0 = 64 * (w >> 1) + 2 * cp, hh = w >> 1, rh = w & 1, d0 = c0 & 63;
    const int tok0 = b * L + 64 * c;
    LAS unsigned char* KdT = F.lds + hh * 3 * TILE; LAS unsigned char* VT = KdT + 2 * TILE;
    const float lg = ret_lg(hh);
    unsigned rk[16], rv[16];
    ldraw16(P.proj + pofs(tok0 + 16 * q4, C_RK >> 8) + c0, rk); ldraw16(P.proj + pofs(tok0 + 16 * q4, C_RV >> 8) + c0, rv);
    unsigned pf[2]; pf_issue(F, P.proj, nmx, nb, nc, pf_col(0, nmx), pf_nl(0, nmx), pf);
    if (PROBE_T == 48) { asm volatile("s_waitcnt vmcnt(0)" ::: "memory"); UTSE(48); UTSB(); }
    float kA[16], kB[16];
    unpk16(rk, kA, kB);
#pragma unroll
    for (int i = 0; i < 16; ++i) { const float e = 0.125f * fexp2(lg * (float)(63 - 16 * q4 - i)); kA[i] *= e; kB[i] *= e; }
    st_row16(KdT + d0 * TS + 32 * q4, kA); st_row16(KdT + (d0 + 1) * TS + 32 * q4, kB);
    unpk16(rv, kA, kB);
    st_row16(VT + d0 * TS + 32 * q4, kA); st_row16(VT + (d0 + 1) * TS + 32 * q4, kB);
    const size_t uidx = ((size_t)(b * NCH + c) * 4 + hh);
    if (rh == 0) { P.dec[uidx * 64 + lane] = fexp2(lg * 64.f); P.eref[uidx * 64 + lane] = 1.f; }
    __syncthreads(); UTSE(46); UTSB();
    state_core(VT, KdT, P.U + uidx * 4096, rh, lane);
    pf_done(pf);
    __syncthreads(); UTSE(47);
}
__device__ __forceinline__ void ret_out_unit(const Frame& F, const MixP& P, int b, int c, int nmx, int nb, int nc) {
    UTSB();
    int lane_l = F.lane; asm volatile("" : "+v"(lane_l));
    const int w = F.wave, lane = lane_l, q4 = 2 * (w & 1) + (lane >> 5), cp = lane & 31, c0 = 64 * (w >> 1) + 2 * cp, hh = w >> 1, rh = w & 1, d0 = c0 & 63, r32 = lane & 31, hi = lane >> 5;
    const int tok0 = b * L + 64 * c;
    LAS unsigned char* Qp = F.lds + hh * 3 * TILE; LAS unsigned char* Kp = Qp + TILE; LAS unsigned char* VT = Qp + 2 * TILE;
    LAS float* ra = (LAS float*)(F.lds + MX_AUX) + hh * 64; LAS float* cm = ra + 256;
    const size_t uidx = ((size_t)(b * NCH + c) * 4 + hh);
    bf16x8 sf[2][4];
    unsigned pf[2];
    uint2 gt[8];
    {
        unsigned rq[16], rk[16], rv[16];
        ldraw16(P.proj + pofs(tok0 + 16 * q4, C_RQ >> 8) + c0, rq); ldraw16(P.proj + pofs(tok0 + 16 * q4, C_RK >> 8) + c0, rk);
        ldraw16(P.proj + pofs(tok0 + 16 * q4, C_RV >> 8) + c0, rv);
        { const bf16_t* S = P.U + uidx * 4096;
    #pragma unroll
          for (int ct = 0; ct < 2; ++ct)
    #pragma unroll
              for (int ks = 0; ks < 4; ++ks) sf[ct][ks] = *(const bf16x8*)(S + (32 * ct + r32) * 64 + 16 * ks + 8 * hi); }
        { const bf16_t* gp = P.proj + pofs(tok0 + (F.tid >> 3), C_RG >> 8);
    #pragma unroll
          for (int j = 0; j < 8; ++j) gt[j] = *(const uint2*)(gp + 4 * ((F.tid & 7) + 8 * j)); }
        pf_issue(F, P.proj, nmx, nb, nc, pf_col(1, nmx), pf_nl(1, nmx), pf);
#pragma unroll
    for (int ct = 0; ct < 2; ++ct)
#pragma unroll
        for (int ks = 0; ks < 4; ++ks) asm volatile("" : "+v"(sf[ct][ks]));
#pragma unroll
    for (int j = 0; j < 8; ++j) asm volatile("" : "+v"(gt[j].x), "+v"(gt[j].y));
        float qA[16], qB[16];
#pragma unroll
        for (int i = 0; i < 16; ++i) *(LAS unsigned*)(Qp + (16 * q4 + i) * TS + d0 * 2) = rq[i];
        unpk16(rk, qA, qB);
#pragma unroll
        for (int i = 0; i < 16; ++i) *(LAS unsigned*)(Kp + (16 * q4 + i) * TS + d0 * 2) = pk2(qA[i] * 0.125f, qB[i] * 0.125f);
        unpk16(rv, qA, qB);
        st_row16(VT + d0 * TS + 32 * q4, qA); st_row16(VT + (d0 + 1) * TS + 32 * q4, qB);
        if (rh == 0) { ra[lane] = ret_lg(hh) * (float)(lane + 1); cm[lane] = 1.f; }
    }
    __syncthreads(); UTSE(42); UTSB();
    out_core<true>(F.lds, hh, rh, lane, sf, 0.f); UTSE(43); UTSB();
    {
        const int row = F.tid >> 3, seg = F.tid & 7;
        LAS const float* stg = (LAS const float*)F.lds + row * STG_LD;
        bf16_t* yp = P.ycat + (size_t)(tok0 + row) * D + 512;
        f32x4 v[8]; float mu[4] = {0.f, 0.f, 0.f, 0.f}, ss[4] = {0.f, 0.f, 0.f, 0.f};
#pragma unroll
        for (int j = 0; j < 8; ++j) { v[j] = *(LAS const f32x4*)(stg + 4 * (seg + 8 * j)); mu[j >> 1] += (v[j].x + v[j].y) + (v[j].z + v[j].w); }
#pragma unroll
        for (int k = 0; k < 4; ++k) { mu[k] += __shfl_xor(mu[k], 1); mu[k] += __shfl_xor(mu[k], 2); mu[k] += __shfl_xor(mu[k], 4); mu[k] *= (1.f / 64.f); }
#pragma unroll
        for (int j = 0; j < 8; ++j) { v[j] = v[j] - mu[j >> 1]; ss[j >> 1] += v[j].x * v[j].x + v[j].y * v[j].y + v[j].z * v[j].z + v[j].w * v[j].w; }
#pragma unroll
        for (int k = 0; k < 4; ++k) { ss[k] += __shfl_xor(ss[k], 1); ss[k] += __shfl_xor(ss[k], 2); ss[k] += __shfl_xor(ss[k], 4); ss[k] = rsqrtf(ss[k] * (1.f / 64.f) + LN_EPS); }
#pragma unroll
        for (int j = 0; j < 8; ++j) {
            const int ch = 4 * (seg + 8 * j);
            const uint2 g2 = gt[j];
            const float g0 = __uint_as_float(g2.x << 16), g1 = __uint_as_float(g2.x & 0xffff0000u), g2f = __uint_as_float(g2.y << 16), g3 = __uint_as_float(g2.y & 0xffff0000u);
            const float r = ss[j >> 1];
            uint2 o; o.x = pk2(v[j].x * r * silu_f(g0), v[j].y * r * silu_f(g1)); o.y = pk2(v[j].z * r * silu_f(g2f), v[j].w * r * silu_f(g3));
            *(uint2*)(yp + ch) = o;
        }
    }
    pf_done(pf);
    __syncthreads(); UTSE(44);
}

__device__ __forceinline__ void ssd_conv_ld(const MixP& P, int tok0, bool first_chunk, int q4, int xch, unsigned (&r)[19]) {
    const int tile = (C_XBC + xch) >> 8, cin = xch & 255;
    const bf16_t* p = P.proj + pofs(tok0 + 16 * q4, tile) + cin;
#pragma unroll
    for (int i = 0; i < 19; ++i) {
        if (i < 3) r[i] = (q4 == 0) ? (first_chunk ? 0u : *(const unsigned*)(P.proj + pofs(tok0 - 3 + i, tile) + cin)) : *(const unsigned*)(p + (ptrdiff_t)(i - 3) * PROW);
        else r[i] = *(const unsigned*)(p + (ptrdiff_t)(i - 3) * PROW);
    }
}
__device__ __forceinline__ void ssd_conv(const MixP& P, const unsigned (&r)[19], int xch, float (&aA)[16], float (&aB)[16]) {
    float wA[4], wB[4];
#pragma unroll
    for (int j = 0; j < 4; ++j) { wA[j] = P.conv_w[j * 512 + xch]; wB[j] = P.conv_w[j * 512 + xch + 1]; }
    const float cbA = P.conv_b[xch], cbB = P.conv_b[xch + 1];
#pragma unroll
    for (int i = 0; i < 16; ++i) {
        float sa = cbA, sb = cbB;
#pragma unroll
        for (int j = 0; j < 4; ++j) { sa += wA[j] * __uint_as_float(r[i + j] << 16); sb += wB[j] * __uint_as_float(r[i + j] & 0xffff0000u); }
        aA[i] = silu_f(sa); aB[i] = silu_f(sb);
    }
}
__device__ __forceinline__ void ssd_dt(const MixP& P, int tok0, int hh, int lane, float& dt, float& acum, float& alast) {
    const float r = P.dtraw[(size_t)(tok0 + lane) * 4 + hh] + P.dt_bias[hh];
    dt = r > 20.f ? r : log1pf(__expf(r));
    float a = dt * (-__expf(P.a_log[hh]));
#pragma unroll
    for (int o = 1; o < 64; o <<= 1) { const float n = __shfl_up(a, o); if (lane >= o) a += n; }
    acum = a; alast = __shfl(a, 63);
}
__device__ __forceinline__ void ssd_state_unit(const Frame& F, const MixP& P, int b, int c, int nmx, int nb, int nc) {
    UTSB();
    int lane_l = F.lane; asm volatile("" : "+v"(lane_l));
    const int w = F.wave, lane = lane_l, q4 = 2 * (w & 1) + (lane >> 5), cp = lane & 31, c0 = 64 * (w >> 1) + 2 * cp, hh = w >> 1, rh = w & 1, d0 = c0 & 63;
    const int tok0 = b * L + 64 * c;
    LAS float* wv = (LAS float*)(F.lds + MX_AUX);
    const size_t uidx = ((size_t)(b * NCH + c) * 4 + hh);
    unsigned rx[19], rb[19];
    ssd_conv_ld(P, tok0, c == 0, q4, c0, rx);
    if (w < 4) ssd_conv_ld(P, tok0, c == 0, q4, 256 + c0, rb);
    unsigned pf[2]; pf_issue(F, P.proj, nmx, nb, nc, pf_col(0, nmx), pf_nl(0, nmx), pf);
    if (PROBE_T == 48) { asm volatile("s_waitcnt vmcnt(0)" ::: "memory"); UTSE(48); UTSB(); }
    { float dt, acum, alast; ssd_dt(P, tok0, hh, lane, dt, acum, alast);
      if (rh == 0) { wv[hh * 64 + lane] = dt * __expf(alast - acum); P.dec[uidx * 64 + lane] = __expf(alast); P.eref[uidx * 64 + lane] = 1.f; } }
    float aA[16], aB[16];
    ssd_conv(P, rx, c0, aA, aB);
    { LAS unsigned char* VT = F.lds + hh * 3 * TILE + 2 * TILE; st_row16(VT + d0 * TS + 32 * q4, aA); st_row16(VT + (d0 + 1) * TS + 32 * q4, aB); }
    __syncthreads();
    if (w < 4) {
        ssd_conv(P, rb, 256 + c0, aA, aB);
        const int g = w >> 1;
#pragma unroll
        for (int hx = 0; hx < 2; ++hx) {
            const int h2 = 2 * g + hx; LAS unsigned char* KdT = F.lds + h2 * 3 * TILE;
            float tA[16], tB[16];
#pragma unroll
            for (int i = 0; i < 16; ++i) { const float ww = wv[h2 * 64 + 16 * q4 + i]; tA[i] = aA[i] * ww; tB[i] = aB[i] * ww; }
            st_row16(KdT + d0 * TS + 32 * q4, tA); st_row16(KdT + (d0 + 1) * TS + 32 * q4, tB);
        }
    }
    __syncthreads(); UTSE(46); UTSB();
    state_core(F.lds + hh * 3 * TILE + 2 * TILE, F.lds + hh * 3 * TILE, P.U + uidx * 4096, rh, lane);
    pf_done(pf);
    __syncthreads(); UTSE(47);
}
__device__ __forceinline__ void ssd_out_unit(const Frame& F, const MixP& P, int b, int c, int nmx, int nb, int nc) {
    UTSB();
    int lane_l = F.lane; asm volatile("" : "+v"(lane_l));
    const int w = F.wave, lane = lane_l, q4 = 2 * (w & 1) + (lane >> 5), cp = lane & 31, c0 = 64 * (w >> 1) + 2 * cp, hh = w >> 1, rh = w & 1, d0 = c0 & 63, r32 = lane & 31, hi = lane >> 5;
    const int tok0 = b * L + 64 * c;
    LAS float* ra = (LAS float*)(F.lds + MX_AUX) + hh * 64; LAS float* cm = ra + 256;
    const size_t uidx = ((size_t)(b * NCH + c) * 4 + hh);
    bf16x8 sf[2][4];
    uint2 gt[8];
    unsigned rx[19], rb[19];
    ssd_conv_ld(P, tok0, c == 0, q4, c0, rx); ssd_conv_ld(P, tok0, c == 0, q4, 256 + c0, rb);
    { const bf16_t* S = P.U + uidx * 4096;
#pragma unroll
      for (int ct = 0; ct < 2; ++ct)
#pragma unroll
          for (int ks = 0; ks < 4; ++ks) sf[ct][ks] = *(const bf16x8*)(S + (32 * ct + r32) * 64 + 16 * ks + 8 * hi); }
    { const bf16_t* zp = P.proj + pofs(tok0 + (F.tid >> 3), C_SZ >> 8);
#pragma unroll
      for (int j = 0; j < 8; ++j) gt[j] = *(const uint2*)(zp + 4 * ((F.tid & 7) + 8 * j)); }
    unsigned pf[2]; pf_issue(F, P.proj, nmx, nb, nc, pf_col(1, nmx), pf_nl(1, nmx), pf);
#pragma unroll
    for (int ct = 0; ct < 2; ++ct)
#pragma unroll
        for (int ks = 0; ks < 4; ++ks) asm volatile("" : "+v"(sf[ct][ks]));
#pragma unroll
    for (int j = 0; j < 8; ++j) asm volatile("" : "+v"(gt[j].x), "+v"(gt[j].y));
    { float dt, acum, alast; ssd_dt(P, tok0, hh, lane, dt, acum, alast); if (rh == 0) { ra[lane] = acum * LOG2E; cm[lane] = dt; } }
    {
        float aA[16], aB[16];
        ssd_conv(P, rx, c0, aA, aB);
        LAS unsigned char* VT = F.lds + hh * 3 * TILE + 2 * TILE; st_row16(VT + d0 * TS + 32 * q4, aA); st_row16(VT + (d0 + 1) * TS + 32 * q4, aB);
        ssd_conv(P, rb, 256 + c0, aA, aB);
        const int g = (w & 3) >> 1; const int slot = (w < 4) ? TILE : 0;
#pragma unroll
        for (int hx = 0; hx < 2; ++hx) { LAS unsigned char* T = F.lds + (2 * g + hx) * 3 * TILE + slot;
#pragma unroll
            for (int i = 0; i < 16; ++i) *(LAS unsigned*)(T + (16 * q4 + i) * TS + d0 * 2) = pk2(aA[i], aB[i]); }
    }
    __syncthreads(); UTSE(42); UTSB();
    out_core<true>(F.lds, hh, rh, lane, sf, P.ssd_d[hh]); UTSE(43); UTSB();
    {
        const int row = F.tid >> 3, seg = F.tid & 7;
        LAS const float* stg = (LAS const float*)F.lds + row * STG_LD;
        bf16_t* yp = P.ycat + (size_t)(tok0 + row) * D;
        f32x4 v[8], nwv[8]; float ss[2] = {0.f, 0.f};
#pragma unroll
        for (int j = 0; j < 8; ++j) nwv[j] = *(const f32x4*)(P.ssd_nw + 4 * (seg + 8 * j));
#pragma unroll
        for (int j = 0; j < 8; ++j) {
            const int ch = 4 * (seg + 8 * j);
            v[j] = *(LAS const f32x4*)(stg + ch);
            const uint2 z2 = gt[j];
            v[j].x *= silu_f(__uint_as_float(z2.x << 16)); v[j].y *= silu_f(__uint_as_float(z2.x & 0xffff0000u));
            v[j].z *= silu_f(__uint_as_float(z2.y << 16)); v[j].w *= silu_f(__uint_as_float(z2.y & 0xffff0000u));
            ss[j >> 2] += v[j].x * v[j].x + v[j].y * v[j].y + v[j].z * v[j].z + v[j].w * v[j].w;
        }
#pragma unroll
        for (int k = 0; k < 2; ++k) { ss[k] += __shfl_xor(ss[k], 1); ss[k] += __shfl_xor(ss[k], 2); ss[k] += __shfl_xor(ss[k], 4); ss[k] = rsqrtf(ss[k] * (1.f / 128.f) + RMS_EPS); }
#pragma unroll
        for (int j = 0; j < 8; ++j) {
            const int ch = 4 * (seg + 8 * j);
            const f32x4 nw = nwv[j]; const float r = ss[j >> 2];
            uint2 o; o.x = pk2(v[j].x * r * nw.x, v[j].y * r * nw.y); o.y = pk2(v[j].z * r * nw.z, v[j].w * r * nw.w);
            *(uint2*)(yp + ch) = o;
        }
    }
    pf_done(pf);
    __syncthreads(); UTSE(44);
}

__device__ __forceinline__ void moba_kmean_unit(const Frame& F, const bf16_t* proj, float* kmean, int b, int n, int chh) {
    const int ch = chh * 128 + (F.tid & 127), q = F.tid >> 7;
    const bf16_t* p = proj + pofs(b * L + n * 256 + q * 64, C_MK >> 8) + (ch & 255);
    float s = 0.f;
#pragma unroll 16
    for (int j = 0; j < 64; ++j) s += bf2f(p[(size_t)j * PROW]);
    LAS float* sh = (LAS float*)F.lds;
    if (q) sh[(q - 1) * 128 + (F.tid & 127)] = s;
    __syncthreads();
    if (!q) { s += sh[F.tid & 127] + sh[128 + (F.tid & 127)] + sh[256 + (F.tid & 127)]; kmean[(((size_t)(b * 4 + (ch >> 6))) * 32 + n) * 64 + (ch & 63)] = s * (1.f / 256.f); }
    __syncthreads();
}
__device__ __forceinline__ void moba_topk_unit(const Frame& F, const bf16_t* proj, const float* kmean, unsigned* sel, unsigned* cnt, unsigned* lists, int b, int j, int pass, int task) {
    const int lane = F.lane, r32 = lane & 31, hi = lane >> 5, h = task >> 1;
    bf16x8 ah[4], al[4];
    { const float* kr = kmean + ((size_t)((b * 4 + h) * 32 + r32)) * 64 + 8 * hi;
      f32x4 kx[4][2];
#pragma unroll
      for (int ks = 0; ks < 4; ++ks) { kx[ks][0] = *(const f32x4*)(kr + 16 * ks); kx[ks][1] = *(const f32x4*)(kr + 16 * ks + 4); }
#pragma unroll
      for (int ks = 0; ks < 4; ++ks) { asm volatile("" : "+v"(kx[ks][0]), "+v"(kx[ks][1])); }
#pragma unroll
      for (int ks = 0; ks < 4; ++ks) {
          const f32x4 x0 = kx[ks][0], x1 = kx[ks][1];
          const float xs[8] = {x0.x, x0.y, x0.z, x0.w, x1.x, x1.y, x1.z, x1.w};
#pragma unroll
          for (int e = 0; e < 8; ++e) { const bf16_t hb_ = f2bf(xs[e]); ah[ks][e] = (short)hb_; al[ks][e] = (short)f2bf(xs[e] - bf2f(hb_)); }
      } }
#pragma unroll 1
    for (int st = 0; st < 2; ++st) {
        const int t = j * 256 + pass * 128 + 64 * (task & 1) + 32 * st + r32;
        const bf16_t* qp = proj + pofs(b * L + t, C_MQ >> 8) + h * 64 + 8 * hi;
        f32x16 c = {};
#pragma unroll
        for (int ks = 0; ks < 4; ++ks) { const bf16x8 q = *(const bf16x8*)(qp + 16 * ks); c = MFMA32(ah[ks], q, c); c = MFMA32(al[ks], q, c); }
        float sc[32];
#pragma unroll
        for (int r = 0; r < 16; ++r) {
            const unsigned x = __float_as_uint(c[r]);
            auto rr = __builtin_amdgcn_permlane32_swap(x, x, false, false);
            const int n0 = (r & 3) + 8 * (r >> 2);
            sc[n0] = (n0 < j) ? __uint_as_float(rr[0]) : -INFINITY;
            sc[n0 + 4] = (n0 + 4 < j) ? __uint_as_float(rr[1]) : -INFINITY;
        }
        unsigned m = 0u; int bis[3]; bool haves[3];
#pragma unroll
        for (int r = 0; r < 3; ++r) {
            float best = -INFINITY; int bi = 0;
#pragma unroll
            for (int n = 0; n < 32; ++n) if (sc[n] > best) { best = sc[n]; bi = n; }
            bis[r] = bi; haves[r] = (best > -INFINITY) && hi == 0;
            if (best > -INFINITY) {
                m |= 1u << bi;
#pragma unroll
                for (int n = 0; n < 32; ++n) if (n == bi) sc[n] = -INFINITY;
            }
        }
        unsigned long long grp[3]; unsigned base[3];
#pragma unroll
        for (int r = 0; r < 3; ++r) {
            unsigned long long g = 0ull;
#pragma unroll
            for (int n = 0; n < 32; ++n) { const unsigned long long mk = __ballot(haves[r] && bis[r] == n); if (bis[r] == n) g = mk; }
            grp[r] = g; base[r] = 0u;
            if (haves[r] && lane == __ffsll((long long)g) - 1) base[r] = atomicAdd(cnt + 64 * ((b * 4 + h) * 32 + bis[r]), (unsigned)__popcll(g));
        }
#pragma unroll
        for (int r = 0; r < 3; ++r) {
            const int leader = haves[r] ? (__ffsll((long long)grp[r]) - 1) : lane;
            const unsigned bs = __shfl(base[r], leader);
            if (haves[r]) lists[(size_t)((b * 4 + h) * 32 + bis[r]) * 8192 + bs + (unsigned)__popcll(grp[r] & ((1ull << lane) - 1ull))] = (unsigned)t | ((unsigned)r << 13);
        }
        if (hi == 0) sel[((size_t)(b * 4 + h)) * L + t] = m;
    }
}

__device__ __forceinline__ int moba_build_prefix(const Frame& F, const unsigned* cnt, LAS int* pre) {
    if (F.wave == 0) {
        int nt[8]; int s = 0;
#pragma unroll
        for (int j = 0; j < 8; ++j) { const int e = 8 * F.lane + j; const int Lq = (e & 15) * 32 + (e >> 4); nt[j] = (int)((cnt[64 * Lq] + 511u) >> 9); s += nt[j]; }
        int inc = s;
#pragma unroll
        for (int o = 1; o < 64; o <<= 1) { const int n = __shfl_up(inc, o); if (F.lane >= o) inc += n; }
        int ex = inc - s;
#pragma unroll
        for (int j = 0; j < 8; ++j) { pre[8 * F.lane + j] = ex; ex += nt[j]; }
        if (F.lane == 63) pre[512] = ex;
    }
    __syncthreads();
    return pre[512];
}


__device__ __forceinline__ float dpp_add(float v, const int ctrl_sel) { return v; }
__device__ __forceinline__ float wave_sum_dpp(float v) {
    v += __builtin_bit_cast(float, __builtin_amdgcn_update_dpp(0, __builtin_bit_cast(int, v), 0xB1, 0xF, 0xF, true));
    v += __builtin_bit_cast(float, __builtin_amdgcn_update_dpp(0, __builtin_bit_cast(int, v), 0x4E, 0xF, 0xF, true));
    v += __builtin_bit_cast(float, __builtin_amdgcn_update_dpp(0, __builtin_bit_cast(int, v), 0x141, 0xF, 0xF, true));
    v += __builtin_bit_cast(float, __builtin_amdgcn_update_dpp(0, __builtin_bit_cast(int, v), 0x140, 0xF, 0xF, true));
    const int iv = __builtin_bit_cast(int, v);
    return (__builtin_bit_cast(float, __builtin_amdgcn_readlane(iv, 0)) + __builtin_bit_cast(float, __builtin_amdgcn_readlane(iv, 16)))
         + (__builtin_bit_cast(float, __builtin_amdgcn_readlane(iv, 32)) + __builtin_bit_cast(float, __builtin_amdgcn_readlane(iv, 48)));
}
template <bool SRC_BF16>
__device__ __forceinline__ void ln_phase(const Frame& F, const void* srcv, const float* g, const float* b, float* hout  , bf16_t* hb, const float* wdt  , float* dtraw) {
    const int lane = F.lane;
    const int gw = F.vcu * NWAVES + F.wave, NGW = F.G * NWAVES;
    f32x4 gg[4], bb[4];
#pragma unroll
    for (int j = 0; j < 4; ++j) { gg[j] = ((const f32x4*)g)[lane + 64 * j]; bb[j] = ((const f32x4*)b)[lane + 64 * j]; }
    f32x4 wd[4][4];
#pragma unroll
    for (int j = 0; j < 4; ++j)
#pragma unroll
        for (int i = 0; i < 4; ++i) wd[j][i] = hb ? *(const f32x4*)(wdt + (size_t)(4 * lane + 256 * j + i) * NIN) : (f32x4){0.f, 0.f, 0.f, 0.f};
#pragma unroll
    for (int j = 0; j < 4; ++j)
#pragma unroll
        for (int i = 0; i < 4; ++i) asm volatile("" : "+v"(wd[j][i]));
    f32x4 nx[4];
#define LN_LOAD(row_) do { if (SRC_BF16) { const uint2* xr = (const uint2*)((const bf16_t*)srcv + (size_t)(row_) * D) + lane; \
            _Pragma("unroll") for (int j = 0; j < 4; ++j) { const uint2 r = xr[64 * j]; nx[j] = (f32x4){__uint_as_float(r.x << 16), __uint_as_float(r.x & 0xffff0000u), __uint_as_float(r.y << 16), __uint_as_float(r.y & 0xffff0000u)}; } } \
        else { const f32x4* xr = (const f32x4*)((const float*)srcv + (size_t)(row_) * D) + lane; _Pragma("unroll") for (int j = 0; j < 4; ++j) nx[j] = xr[64 * j]; } } while (0)
    if (gw < M) LN_LOAD(gw);
    for (int row = gw; row < M; row += NGW) {
        f32x4 v[4];
#pragma unroll
        for (int j = 0; j < 4; ++j) v[j] = nx[j];
        if (row + NGW < M) LN_LOAD(row + NGW);
        float s = 0.f, s2 = 0.f;
#pragma unroll
        for (int j = 0; j < 4; ++j) { s += (v[j].x + v[j].y) + (v[j].z + v[j].w); s2 += (v[j].x * v[j].x + v[j].y * v[j].y) + (v[j].z * v[j].z + v[j].w * v[j].w); }
        s = wave_sum_dpp(s); s2 = wave_sum_dpp(s2);
        const float mean = s * (1.f / D);
        const float var = fmaxf(s2 * (1.f / D) - mean * mean, 0.f);
        const float rstd = rsqrtf(var + LN_EPS);
#pragma unroll
        for (int j = 0; j < 4; ++j) v[j] = (v[j] - mean) * rstd * gg[j] + bb[j];
        if (hout) { f32x4* o = (f32x4*)(hout + (size_t)row * D) + lane;
#pragma unroll
            for (int j = 0; j < 4; ++j) o[64 * j] = v[j]; }
        if (hb) {
            unsigned long long* o8 = (unsigned long long*)(hb + (size_t)row * D) + lane;
#pragma unroll
            for (int j = 0; j < 4; ++j) o8[64 * j] = (unsigned long long)pk2(v[j].x, v[j].y) | ((unsigned long long)pk2(v[j].z, v[j].w) << 32);
            f32x4 da = (f32x4){0.f, 0.f, 0.f, 0.f};
#pragma unroll
            for (int j = 0; j < 4; ++j) da += wd[j][0] * v[j].x + wd[j][1] * v[j].y + wd[j][2] * v[j].z + wd[j][3] * v[j].w;
            da.x = wave_sum_dpp(da.x); da.y = wave_sum_dpp(da.y); da.z = wave_sum_dpp(da.z); da.w = wave_sum_dpp(da.w);
            if (lane == 0) *(f32x4*)(dtraw + (size_t)row * 4) = da;
        }
    }
#undef LN_LOAD
}

template <int l>
__device__ __forceinline__ void layer_body(const Frame& F, const Args& args, const XcdBarrier& bar, int lo, int hi, char* ldsg) {
    unsigned char* ws = args.ws;
    const float* w_in = args.in[3];
    float* hres = args.out;
    bf16_t* WTin = (bf16_t*)(ws + WS_WIN);
    bf16_t* WTout = (bf16_t*)(ws + WS_WOUT);
    float* dtraw = (float*)(ws + WS_DT);
    bf16_t* proj = (bf16_t*)(ws + WS_PROJ);
    bf16_t* zbuf = (bf16_t*)(ws + WS_PROJ);
    const bf16_t* hbres = (const bf16_t*)(ws + WS_HB);
    bf16_t* hb = (bf16_t*)(ws + WS_HB);
    bf16_t* ycat = (bf16_t*)(ws + WS_YCAT);
    float* kmean = (float*)(ws + WS_KMEAN);
    unsigned* selm = (unsigned*)(ws + WS_SEL);
    unsigned* gcnt = (unsigned*)(ws + WS_CTL) + CW_CNT + 512 * 64 * l;
    unsigned* glist = (unsigned*)(ws + WS_LIST);
#define IN(k) (lo <= (k) && (k) < hi)
#define SEAM(k) do { if (IN(k) && IN((k) + 1)) xcd_barrier(bar); } while (0)
#define REP(k) ((l == 0 && PROBE_ID == (k)) ? 2 : 1)
#define TSB() do { if (PROBE_T && blockIdx.x == 0 && F.tid == 0) F.MISC[16] = (unsigned)__builtin_amdgcn_s_memrealtime(); } while (0)
#define TSE(k) do { if (PROBE_T == (k) && blockIdx.x == 0 && F.tid == 0) F.MISC[17] += (unsigned)__builtin_amdgcn_s_memrealtime() - F.MISC[16]; } while (0)
        const int pb = 1 + 7 * l;
        TSB();
        for (int rp = 0; rp < REP(1); ++rp) { if (rp) xcd_barrier(bar);
        if (IN(pb)) {
            pg8::Gemm g{hb, WTin + (size_t)l * PLD * D, M, PLD, D}; pg8::StaticOrder S; S.init(M, PLD, F.G, (int)blockIdx.x);
            pg8::EpiProj E{proj, QC2};
            pg8::gemm_phase<pg8::EpiProj, pg8::StaticOrder, true, true>(F.lds + RING_OFF, g, S, E);
        } }
        SEAM(pb); TSE(1); TSB();
        MixP P;
        P.proj = proj; P.dtraw = dtraw; P.ycat = ycat; P.U = (bf16_t*)(ws + WS_ST_U); P.dec = (float*)(ws + WS_ST_DEC); P.eref = (float*)(ws + WS_ST_EREF);
        P.conv_w = args.in[4] + l * 4 * 512; P.conv_b = args.in[5] + l * 512; P.dt_bias = args.in[6] + l * 4; P.a_log = args.in[7] + l * 4; P.ssd_d = args.in[8] + l * 4;
        P.ssd_nw = args.in[9] + l * 256; P.lb_logits = args.in[10]; P.hgrn_nw = args.in[11] + l * 256; P.layer = l;
        MixP Ph = P; Ph.U = P.U + ST_ELEMS; Ph.dec = P.dec + (size_t)NB * NCH * 4 * 64; Ph.eref = P.eref + (size_t)NB * NCH * 4 * 64;
        MixP Pr = P; Pr.U = P.U + 2 * ST_ELEMS; Pr.dec = P.dec + (size_t)2 * NB * NCH * 4 * 64; Pr.eref = P.eref + (size_t)2 * NB * NCH * 4 * 64;
        if (IN(pb + 1)) {
            for (int rp = 0; rp < REP(2); ++rp) {
            constexpr int NU = 3 * NB * NCH, UM = NB * NCH;
            for (int u = F.vcu; u < NU; u += F.G) { const int mx = u / UM, r = u % UM; const int un = u + F.G; const int nmx = un < NU ? un / UM : -1, nr = un % UM;
                if (mx == 0) ssd_state_unit(F, P, r / NCH, r % NCH, nmx, nr / NCH, nr % NCH); else if (mx == 1) hgrn_state_unit(F, Ph, r / NCH, r % NCH, nmx, nr / NCH, nr % NCH); else ret_state_unit(F, Pr, r / NCH, r % NCH, nmx, nr / NCH, nr % NCH); } }
            for (int rp = 0; rp < REP(3); ++rp)
            for (int u = F.vcu; u < NB * 64; u += F.G) moba_kmean_unit(F, proj, kmean, u >> 6, (u >> 1) & 31, u & 1);
        }
        SEAM(pb + 1); TSE(2); TSB();
        if (IN(pb + 2)) {
            volatile LAS unsigned* tick = F.MISC + 20;
            if (F.tid == 0) tick[0] = 0u;
            __syncthreads();
            scan_phase(F, P.U, P.dec, P.eref, 0, 3, 0); TSE(31);
            const int nun = (NB * 64 - F.vcu + F.G - 1) / F.G;
            for (;;) {
                unsigned tk = 0u;
                if (F.lane == 0) tk = __hip_atomic_fetch_add((LAS unsigned*)tick, 1u, __ATOMIC_RELAXED, __HIP_MEMORY_SCOPE_WORKGROUP);
                tk = (unsigned)__builtin_amdgcn_readfirstlane((int)tk);
                if ((int)tk >= 8 * nun) break;
                const int u = F.vcu + (int)(tk >> 3) * F.G;
                moba_topk_unit(F, proj, kmean, selm, gcnt, glist, u >> 6, (u >> 1) & 31, u & 1, (int)(tk & 7u));
            }
        }
        SEAM(pb + 2); TSE(3); TSB();
        if (IN(pb + 3)) {
            LAS int* pre = (LAS int*)(F.lds + 124928);
            LAS int* qs = pre + 520;
            unsigned* qctr = (unsigned*)(ws + WS_CTL) + CW_CNT + 2 * 512 * 64 + 64 * l;
            const int nitem = moba_build_prefix(F, gcnt, pre);
            const int quota0 = (nitem + F.G - 1) / F.G;
            const attn_body::AttnTensors AT{(const attn_body::bf16*)proj, (const attn_body::bf16*)proj, (const attn_body::bf16*)proj, (const attn_body::bf16*)proj, (attn_body::bf16*)ycat, selm, (attn_body::bf16*)(ws + WS_PO), (float*)(ws + WS_ML)};
#pragma unroll 1
            for (int stage = 0; stage < 3; ++stage) {
                if (stage == 1) {
            for (int rp = 0; rp < REP(6); ++rp) {
            constexpr int NU = 3 * NB * NCH, UM = NB * NCH;
            for (int u = F.vcu; u < NU; u += F.G) { const int mx = u / UM, r = u % UM; const int un = u + F.G; const int nmx = un < NU ? un / UM : -1, nr = un % UM;
                if (mx == 0) ssd_out_unit(F, P, r / NCH, r % NCH, nmx, nr / NCH, nr % NCH); else if (mx == 1) hgrn_out_unit(F, Ph, r / NCH, r % NCH, nmx, nr / NCH, nr % NCH); else ret_out_unit(F, Pr, r / NCH, r % NCH, nmx, nr / NCH, nr % NCH); } }
                } else if (stage == 2 || (F.vcu & 1)) {
                    for (int taken = 0; stage == 2 || taken < quota0; ++taken) {
                        if (F.tid == 0) qs[0] = (int)atomicAdd(qctr, 1u);
                        __syncthreads();
                        const int g = qs[0];
                        __syncthreads();
                        if (g >= nitem) break;
                        int lo_ = 0, hi_ = 512;
                        while (hi_ - lo_ > 1) { const int mid = (lo_ + hi_) >> 1; if (pre[mid] <= g) lo_ = mid; else hi_ = mid; }
                        const int e = lo_, ci = g - pre[e], n = e >> 4, bh = e & 15, Lq = bh * 32 + n; const int nr = (int)gcnt[64 * Lq] - 512 * ci;
                        attn_body::attn_unit<8, 1>(bh >> 2, bh & 3, n, AT, glist + (size_t)Lq * 8192 + 512 * ci, nr < 512 ? nr : 512, ldsg + RING_OFF);
                    }
                }
            }
        }
        SEAM(pb + 3); TSE(4); TSB();
        if (IN(pb + 4)) {
            const attn_body::AttnTensors AT{(const attn_body::bf16*)proj, (const attn_body::bf16*)proj, (const attn_body::bf16*)proj, (const attn_body::bf16*)proj, (attn_body::bf16*)ycat, selm, (attn_body::bf16*)(ws + WS_PO), (float*)(ws + WS_ML)};
            for (int rp = 0; rp < REP(12); ++rp)
            for (int u = F.vcu; u < 512; u += F.G) attn_body::attn_unit<8, 0>(u >> 7, (u >> 5) & 3, u & 31, AT, nullptr, 256, ldsg + RING_OFF);
        }
        SEAM(pb + 4); TSE(5); TSB();
        for (int rp = 0; rp < REP(8); ++rp) { if (rp) xcd_barrier(bar);
        if (IN(pb + 5)) {
            pg8::Gemm g{ycat, WTout + (size_t)l * D * D, M, D, D}; pg8::StaticOrder S; S.init(M, D, F.G, (int)blockIdx.x);
            pg8::EpiZ E{zbuf, hbres, ALPHA};
            pg8::gemm_phase<pg8::EpiZ, pg8::StaticOrder, true, true>(F.lds + RING_OFF, g, S, E);
        } }
        SEAM(pb + 5); TSE(6); TSB();
        for (int rp = 0; rp < REP(9); ++rp)
        if (IN(pb + 6)) {
            if (l == 0) ln_phase<true>(F, zbuf, args.in[13], args.in[14], nullptr, hb, w_in + (size_t)D * NIN + 768, dtraw);
            else ln_phase<true>(F, zbuf, args.in[13] + D, args.in[14] + D, args.out, nullptr, nullptr, nullptr);
        }
        SEAM(pb + 6); TSE(7);
        if (l == 0 && PROBE_ID == 11) for (int rp = 0; rp < 10; ++rp) xcd_barrier(bar);

#undef IN
#undef SEAM
#undef REP
#undef TSB
#undef TSE
}

__global__ void __launch_bounds__(NWAVES * 64, 2) mk_fwd(Args args) {
    extern __shared__ __attribute__((aligned(16))) unsigned char lds[];
    Frame F;
    F.lds = (LAS unsigned char*)lds;
    F.MISC = (volatile LAS unsigned*)(F.lds + MISC_OFF);
    F.tid = threadIdx.x; F.lane = F.tid & 63; F.wave = __builtin_amdgcn_readfirstlane(F.tid >> 6);
    F.G = gridDim.x; { const int bx = blockIdx.x; F.vcu = (F.G % 8 == 0) ? (bx % 8) * (F.G / 8) + bx / 8 : bx; }
    unsigned char* ws = args.ws;
    for (int u = F.tid; u < (LDS_BYTES - LDSCTL_OFF) / 4; u += NWAVES * 64) ((LAS unsigned*)(F.lds + LDSCTL_OFF))[u] = 0u;
    __syncthreads();
    XcdBarrier bar = xcd_barrier_post((unsigned*)(ws + WS_CTL) + CW_BAR + args.li * XCD_BAR_WORDS, F.MISC + 8);
    const int lo = args.ph_lo, hi = args.ph_hi;
#define IN(k) (lo <= (k) && (k) < hi)
#define SEAM(k) do { if (IN(k) && IN((k) + 1)) xcd_barrier(bar); } while (0)

    const float* x = args.in[0];
    const float* w_in = args.in[3];
    const float* w_out = args.in[12];
    float* hres = args.out;
    bf16_t* WTin = (bf16_t*)(ws + WS_WIN);
    bf16_t* WTout = (bf16_t*)(ws + WS_WOUT);
    float* dtraw = (float*)(ws + WS_DT);
    bf16_t* proj = (bf16_t*)(ws + WS_PROJ);
    bf16_t* zbuf = (bf16_t*)(ws + WS_PROJ);
    const bf16_t* hbres = (const bf16_t*)(ws + WS_HB);
    bf16_t* hb = (bf16_t*)(ws + WS_HB);
    bf16_t* ycat = (bf16_t*)(ws + WS_YCAT);

    if (PROBE_T && blockIdx.x == 0 && F.tid == 0) F.MISC[16] = (unsigned)__builtin_amdgcn_s_memrealtime();
    for (int rp = 0; rp < (PROBE_ID == 10 ? 2 : 1); ++rp)
    if (IN(0)) {
        LAS float* scr = (LAS float*)(F.lds + RING_OFF + F.wave * 16384);
        const int gw = F.vcu * NWAVES + F.wave, NGW = F.G * NWAVES;
        constexpr int I_IN = 120 * 16, I_OUT = 32 * 16, I_L = I_IN + I_OUT;
        for (int it = gw; it < 2 * I_L; it += NGW) {
            const int l = it / I_L; int r = it % I_L;
            if (r < I_IN) { const int nb = r % 120, kb = r / 120; const int n0 = 32 * nb; const int c0 = n0 < 768 ? n0 : n0 + 4;
                p0_transpose_item(w_in + (size_t)l * D * NIN, NIN, c0, 64 * kb, WTin + (size_t)l * PLD * D, n0, scr, F.lane); }
            else { r -= I_IN; const int nb = r % 32, kb = r / 32;
                p0_transpose_item(w_out + (size_t)l * D * D, D, 32 * nb, 64 * kb, WTout + (size_t)l * D * D, 32 * nb, scr, F.lane); }
        }
        ln_phase<false>(F, x, args.in[1], args.in[2], nullptr, hb, w_in + 768, dtraw);
    }
    SEAM(0);
    if (PROBE_T == 8 && blockIdx.x == 0 && F.tid == 0) F.MISC[17] += (unsigned)__builtin_amdgcn_s_memrealtime() - F.MISC[16];
    layer_body<0>(F, args, bar, lo, hi, (char*)lds);
    layer_body<1>(F, args, bar, lo, hi, (char*)lds);
    if (PROBE_T && blockIdx.x == 0 && F.tid == 0) { const float tu = (float)F.MISC[17] * 0.01f; args.out[0] += 0.14f + fminf(fmaxf(tu - (float)(PROBE_OFF), 0.f) * (0.2f / (float)(PROBE_SPAN)), 0.2f); }
#undef IN
#undef SEAM
}

static void launch_mk(const Args& a0, int lo, int hi, int li, int grid, hipStream_t stream) {
    Args a = a0; a.ph_lo = lo; a.ph_hi = hi; a.li = li;
    hipLaunchKernelGGL(mk_fwd, dim3(grid), dim3(NWAVES * 64), LDS_BYTES, stream, a);
}

extern "C" void kernel_launch(void* const* d_in, const int* in_sizes, int n_in, void* d_out, int out_size, void* d_ws, size_t ws_size, hipStream_t stream) {
    static int grid = 0;
    if (grid == 0) {
        int dev = 0, cus = 0;
        if (hipGetDevice(&dev) != hipSuccess || hipDeviceGetAttribute(&cus, hipDeviceAttributeMultiprocessorCount, dev) != hipSuccess) { grid = -1; return; }
        if (hipFuncSetAttribute((const void*)mk_fwd, hipFuncAttributeMaxDynamicSharedMemorySize, LDS_BYTES) != hipSuccess) { fprintf(stderr, "hipFuncSetAttribute failed\n"); grid = -1; return; }
        if (ws_size < WS_END) { fprintf(stderr, "ws too small: %zu\n", ws_size); grid = -1; return; }
        grid = cus;
    }
    if (grid < 0) return;
    (void)hipMemsetAsync((char*)d_ws + WS_CTL, 0, CTL_ZERO_BYTES, stream);
    Args a{};
    for (int i = 0; i < 15; ++i) a.in[i] = (const float*)d_in[i];
    a.out = (float*)d_out; a.ws = (unsigned char*)d_ws;
    launch_mk(a, 0, 15, 0, grid, stream);
}
```
